# Optimizing an MI355X kernel written in HIP

```python
import math
import jax
import jax.numpy as jnp
from jax import lax
import numpy as np

D_MODEL = 1024
BATCH = 8
SEQ = 2048
DEPTH = 2

N_META = 16
BLOCK_Q = 128
MIX_WIDTH = D_MODEL // 2
V_HEAD_DIM = 64
MLA_HEADS = MIX_WIDTH // V_HEAD_DIM
QK_NOPE_DIM = 64
QK_ROPE_DIM = 32
QK_HEAD_DIM = QK_NOPE_DIM + QK_ROPE_DIM
Q_LORA_RANK = 3 * D_MODEL // 8
KV_LORA_RANK = D_MODEL // 4
ROPE_BASE = 10000.0
CONV_WIDTH = MIX_WIDTH
CONV_K = 3
S5_WIDTH = MIX_WIDTH
S5_GROUP = 16
S5_GROUPS = S5_WIDTH // S5_GROUP
S5_STATE = 64
N_BRANCH = 3
D_FF = 128 * ((8 * D_MODEL // 3 + 127) // 128)
ALPHA = (2.0 * DEPTH) ** 0.25
BETA = (8.0 * DEPTH) ** -0.25
LN_EPS = 1e-5
RMS_EPS = 1e-6
IN_SPLITS = (Q_LORA_RANK, KV_LORA_RANK, QK_ROPE_DIM, CONV_WIDTH, CONV_WIDTH, CONV_WIDTH, S5_WIDTH, N_BRANCH * D_MODEL)
D_IN = sum(IN_SPLITS)

kernel_name = "hybrid_mla_shortconv_s5_deepnorm_macaron"


def layer_norm(x, g, b):
    xf = x.astype(jnp.float32)
    mu = jnp.mean(xf, axis=-1, keepdims=True)
    var = jnp.mean(jnp.square(xf - mu), axis=-1, keepdims=True)
    y = (xf - mu) * lax.rsqrt(var + LN_EPS) * g.astype(jnp.float32) + b.astype(jnp.float32)
    return y.astype(x.dtype)


def rms_norm(x, g):
    xf = x.astype(jnp.float32)
    y = xf * lax.rsqrt(jnp.mean(jnp.square(xf), axis=-1, keepdims=True) + RMS_EPS) * g.astype(jnp.float32)
    return y.astype(x.dtype)


def swiglu(x, w_gate, w_up, w_down):
    return (jax.nn.silu(x @ w_gate) * (x @ w_up)) @ w_down


def rope(x, pos):
    d = x.shape[-1]
    inv_freq = ROPE_BASE ** (-jnp.arange(0, d, 2, dtype=jnp.float32) / d)
    ang = pos.astype(jnp.float32)[:, None] * inv_freq[None, :]
    cos = jnp.cos(ang)[None, :, None, :]
    sin = jnp.sin(ang)[None, :, None, :]
    xf = x.astype(jnp.float32)
    x1, x2 = xf[..., : d // 2], xf[..., d // 2:]
    return jnp.concatenate([x1 * cos - x2 * sin, x2 * cos + x1 * sin], axis=-1).astype(x.dtype)


def mla_branch(c_q_raw, c_kv_raw, k_rope_raw, q_norm_g, w_uq, kv_norm_g, w_ukv, w_out):
    B, L, _ = c_q_raw.shape
    pos = jnp.arange(L)
    q = (rms_norm(c_q_raw, q_norm_g) @ w_uq).reshape(B, L, MLA_HEADS, QK_HEAD_DIM)
    kv = (rms_norm(c_kv_raw, kv_norm_g) @ w_ukv).reshape(B, L, MLA_HEADS, QK_NOPE_DIM + V_HEAD_DIM)
    q = jnp.concatenate([q[..., :QK_NOPE_DIM], rope(q[..., QK_NOPE_DIM:], pos)], axis=-1)
    k_rope = rope(k_rope_raw[:, :, None, :], pos)
    k = jnp.concatenate([kv[..., :QK_NOPE_DIM], jnp.broadcast_to(k_rope, (B, L, MLA_HEADS, QK_ROPE_DIM))], axis=-1)
    v = kv[..., QK_NOPE_DIM:]
    pad = (-L) % BLOCK_Q
    padw = ((0, 0), (pad, 0), (0, 0), (0, 0))
    q, k, v = jnp.pad(q, padw), jnp.pad(k, padw), jnp.pad(v, padw)
    n_blocks = (L + pad) // BLOCK_Q
    scale = QK_HEAD_DIM ** -0.5
    outs = []
    for i in range(n_blocks):
        kend = (i + 1) * BLOCK_Q
        qs = q[:, i * BLOCK_Q: kend]
        s = jnp.einsum('bqhd,bkhd->bhqk', qs, k[:, :kend]).astype(jnp.float32) * scale
        qi = i * BLOCK_Q + jnp.arange(BLOCK_Q)
        ki = jnp.arange(kend)
        mask = (ki[None, :] <= qi[:, None]) & (ki[None, :] >= pad)
        s = jnp.where(mask[None, None], s, -1e30)
        p = jax.nn.softmax(s, axis=-1).astype(v.dtype)
        outs.append(jnp.einsum('bhqk,bkhd->bqhd', p, v[:, :kend]))
    o = jnp.concatenate(outs, axis=1)[:, pad:]
    return o.reshape(B, L, MLA_HEADS * V_HEAD_DIM) @ w_out


def short_conv_branch(xbar, b_gate, c_gate, conv_w, conv_b, w_out):
    L = xbar.shape[1]
    u = c_gate * xbar
    up = jnp.pad(u, ((0, 0), (CONV_K - 1, 0), (0, 0)))
    y = conv_b + sum(conv_w[j] * up[:, j: j + L] for j in range(CONV_K))
    return (b_gate * y) @ w_out


def _ssm_combine(e1, e2):
    a1r, a1i, b1r, b1i = e1
    a2r, a2i, b2r, b2i = e2
    ar = a2r * a1r - a2i * a1i
    ai = a2r * a1i + a2i * a1r
    br = a2r * b1r - a2i * b1i + b2r
    bi = a2r * b1i + a2i * b1r + b2i
    return (ar, ai, br, bi)


def s5_branch(u, a_re, a_im, log_dt, b_re, b_im, c_re, c_im, d, w_glu, b_glu, w_out):
    B, L, _ = u.shape
    f32 = jnp.float32
    uf = u.astype(f32).reshape(B, L, S5_GROUPS, S5_GROUP)
    a_re, a_im = a_re.astype(f32), a_im.astype(f32)
    dt = jnp.exp(log_dt.astype(f32))[:, None]
    mag = jnp.exp(dt * a_re)
    ab_re, ab_im = mag * jnp.cos(dt * a_im), mag * jnp.sin(dt * a_im)
    den = a_re * a_re + a_im * a_im
    nr, ni = ab_re - 1.0, ab_im
    coef_re = (nr * a_re + ni * a_im) / den
    coef_im = (ni * a_re - nr * a_im) / den
    b_re, b_im = b_re.astype(f32), b_im.astype(f32)
    bb_re = coef_re[..., None] * b_re - coef_im[..., None] * b_im
    bb_im = coef_re[..., None] * b_im + coef_im[..., None] * b_re
    bu_re = jnp.einsum('gnh,blgh->blgn', bb_re, uf)
    bu_im = jnp.einsum('gnh,blgh->blgn', bb_im, uf)
    shp = (1, L, S5_GROUPS, S5_STATE)
    elems = (jnp.broadcast_to(ab_re[None, None], shp), jnp.broadcast_to(ab_im[None, None], shp), bu_re, bu_im)
    _, _, xr, xi = lax.associative_scan(_ssm_combine, elems, axis=1)
    y = (jnp.einsum('ghn,blgn->blgh', c_re.astype(f32), xr)
         - jnp.einsum('ghn,blgn->blgh', c_im.astype(f32), xi)
         + d.astype(f32) * uf)
    y = jax.nn.gelu(y.reshape(B, L, S5_WIDTH).astype(u.dtype))
    y = y * jax.nn.sigmoid(y @ w_glu + b_glu)
    return y @ w_out


def hybrid_layer(x, ffn1_w_gate, ffn1_w_up, ffn1_w_down, ln1_g, ln1_b, w_in,
                 mla_q_norm_g, mla_w_uq, mla_kv_norm_g, mla_w_ukv, mla_w_o,
                 conv_w, conv_b, conv_w_out,
                 s5_a_re, s5_a_im, s5_log_dt, s5_b_re, s5_b_im, s5_c_re, s5_c_im, s5_d, s5_w_glu, s5_b_glu, s5_w_out,
                 w_o, ln2_g, ln2_b, ffn2_w_gate, ffn2_w_up, ffn2_w_down, ln3_g, ln3_b):
    B, L, _ = x.shape
    x = layer_norm(ALPHA * x + 0.5 * swiglu(x, ffn1_w_gate, ffn1_w_up, ffn1_w_down), ln1_g, ln1_b)
    proj = x @ w_in
    c_q, c_kv, k_rope, xbar, b_gate, c_gate, u_s5, gates = jnp.split(proj, np.cumsum(IN_SPLITS)[:-1].tolist(), axis=-1)
    y_a = mla_branch(c_q, c_kv, k_rope, mla_q_norm_g, mla_w_uq, mla_kv_norm_g, mla_w_ukv, mla_w_o)
    y_b = short_conv_branch(xbar, b_gate, c_gate, conv_w, conv_b, conv_w_out)
    y_c = s5_branch(u_s5, s5_a_re, s5_a_im, s5_log_dt, s5_b_re, s5_b_im, s5_c_re, s5_c_im, s5_d, s5_w_glu, s5_b_glu, s5_w_out)
    g = jax.nn.sigmoid(gates.reshape(B, L, N_BRANCH, D_MODEL))
    mixed = g[:, :, 0] * y_a + g[:, :, 1] * y_b + g[:, :, 2] * y_c
    x = layer_norm(ALPHA * x + mixed @ w_o, ln2_g, ln2_b)
    x = layer_norm(ALPHA * x + 0.5 * swiglu(x, ffn2_w_gate, ffn2_w_up, ffn2_w_down), ln3_g, ln3_b)
    return x


def setup_inputs(seed: int = 0) -> dict:
    key = jax.random.key(seed)
    keys = iter(jax.random.split(key, 48))
    f32 = jnp.float32

    def nrm(shape, scale):
        return jax.random.normal(next(keys), shape, f32) * scale

    def gain(shape):
        return 1.0 + nrm(shape, 0.01)

    Dp = DEPTH
    n_idx = jnp.arange(S5_STATE, dtype=f32)
    inp = {}
    inp["x"] = nrm((BATCH, SEQ, D_MODEL), 1.0)
    inp["meta"] = nrm((N_META, D_MODEL), 1.0)
    inp["ffn1_w_gate"] = nrm((Dp, D_MODEL, D_FF), D_MODEL ** -0.5)
    inp["ffn1_w_up"] = nrm((Dp, D_MODEL, D_FF), D_MODEL ** -0.5)
    inp["ffn1_w_down"] = nrm((Dp, D_FF, D_MODEL), BETA * D_FF ** -0.5)
    inp["ln1_g"] = gain((Dp, D_MODEL))
    inp["ln1_b"] = nrm((Dp, D_MODEL), 0.01)
    inp["w_in"] = nrm((Dp, D_MODEL, D_IN), D_MODEL ** -0.5)
    inp["mla_q_norm_g"] = gain((Dp, Q_LORA_RANK))
    inp["mla_w_uq"] = nrm((Dp, Q_LORA_RANK, MLA_HEADS * QK_HEAD_DIM), Q_LORA_RANK ** -0.5)
    inp["mla_kv_norm_g"] = gain((Dp, KV_LORA_RANK))
    inp["mla_w_ukv"] = nrm((Dp, KV_LORA_RANK, MLA_HEADS * (QK_NOPE_DIM + V_HEAD_DIM)), KV_LORA_RANK ** -0.5)
    inp["mla_w_o"] = nrm((Dp, MLA_HEADS * V_HEAD_DIM, D_MODEL), (MLA_HEADS * V_HEAD_DIM) ** -0.5)
    inp["conv_w"] = nrm((Dp, CONV_K, CONV_WIDTH), CONV_K ** -0.5)
    inp["conv_b"] = nrm((Dp, CONV_WIDTH), 0.01)
    inp["conv_w_out"] = nrm((Dp, CONV_WIDTH, D_MODEL), CONV_WIDTH ** -0.5)
    inp["s5_a_re"] = -0.5 * jnp.exp(nrm((Dp, S5_GROUPS, S5_STATE), 0.01))
    inp["s5_a_im"] = math.pi * n_idx + nrm((Dp, S5_GROUPS, S5_STATE), 0.01)
    inp["s5_log_dt"] = jax.random.uniform(next(keys), (Dp, S5_GROUPS), f32, math.log(1e-3), math.log(1e-1))
    inp["s5_b_re"] = nrm((Dp, S5_GROUPS, S5_STATE, S5_GROUP), (2 * S5_GROUP) ** -0.5)
    inp["s5_b_im"] = nrm((Dp, S5_GROUPS, S5_STATE, S5_GROUP), (2 * S5_GROUP) ** -0.5)
    inp["s5_c_re"] = nrm((Dp, S5_GROUPS, S5_GROUP, S5_STATE), (2 * S5_STATE) ** -0.5)
    inp["s5_c_im"] = nrm((Dp, S5_GROUPS, S5_GROUP, S5_STATE), (2 * S5_STATE) ** -0.5)
    inp["s5_d"] = nrm((Dp, S5_GROUPS, S5_GROUP), 1.0)
    inp["s5_w_glu"] = nrm((Dp, S5_WIDTH, S5_WIDTH), S5_WIDTH ** -0.5)
    inp["s5_b_glu"] = nrm((Dp, S5_WIDTH), 0.01)
    inp["s5_w_out"] = nrm((Dp, S5_WIDTH, D_MODEL), S5_WIDTH ** -0.5)
    inp["w_o"] = nrm((Dp, D_MODEL, D_MODEL), BETA * D_MODEL ** -0.5)
    inp["ln2_g"] = gain((Dp, D_MODEL))
    inp["ln2_b"] = nrm((Dp, D_MODEL), 0.01)
    inp["ffn2_w_gate"] = nrm((Dp, D_MODEL, D_FF), D_MODEL ** -0.5)
    inp["ffn2_w_up"] = nrm((Dp, D_MODEL, D_FF), D_MODEL ** -0.5)
    inp["ffn2_w_down"] = nrm((Dp, D_FF, D_MODEL), BETA * D_FF ** -0.5)
    inp["ln3_g"] = gain((Dp, D_MODEL))
    inp["ln3_b"] = nrm((Dp, D_MODEL), 0.01)
    return inp


def reference(x, meta, ffn1_w_gate, ffn1_w_up, ffn1_w_down, ln1_g, ln1_b, w_in,
              mla_q_norm_g, mla_w_uq, mla_kv_norm_g, mla_w_ukv, mla_w_o,
              conv_w, conv_b, conv_w_out,
              s5_a_re, s5_a_im, s5_log_dt, s5_b_re, s5_b_im, s5_c_re, s5_c_im, s5_d, s5_w_glu, s5_b_glu, s5_w_out,
              w_o, ln2_g, ln2_b, ffn2_w_gate, ffn2_w_up, ffn2_w_down, ln3_g, ln3_b):
    B = x.shape[0]
    h = jnp.concatenate([jnp.broadcast_to(meta[None].astype(x.dtype), (B, N_META, D_MODEL)), x], axis=1)
    for i in range(DEPTH):
        h = hybrid_layer(h, ffn1_w_gate[i], ffn1_w_up[i], ffn1_w_down[i], ln1_g[i], ln1_b[i], w_in[i],
                         mla_q_norm_g[i], mla_w_uq[i], mla_kv_norm_g[i], mla_w_ukv[i], mla_w_o[i],
                         conv_w[i], conv_b[i], conv_w_out[i],
                         s5_a_re[i], s5_a_im[i], s5_log_dt[i], s5_b_re[i], s5_b_im[i], s5_c_re[i], s5_c_im[i],
                         s5_d[i], s5_w_glu[i], s5_b_glu[i], s5_w_out[i],
                         w_o[i], ln2_g[i], ln2_b[i], ffn2_w_gate[i], ffn2_w_up[i], ffn2_w_down[i], ln3_g[i], ln3_b[i])
    return h[:, N_META:]
```

```cpp
#include <hip/hip_runtime.h>
#include <hip/hip_cooperative_groups.h>
#include <cstdint>
#include <cstdio>

#define LAS __attribute__((address_space(3)))
typedef unsigned short bf16_t;
typedef short bf16x8 __attribute__((ext_vector_type(8)));
typedef float f32x4 __attribute__((ext_vector_type(4)));
typedef unsigned u32x4 __attribute__((ext_vector_type(4)));
typedef unsigned u32x2 __attribute__((ext_vector_type(2)));

constexpr int NB = 8, SEQ = 2048, NMETA = 16, LPAD = 2112, DM = 1024, MROWS = NB * SEQ;
constexpr int DFF = 2816, DIN = 5792, NGU = 2 * DFF;
constexpr int PA_N = 2816;
constexpr int OFF_CKV = 384, OFF_KR = 640, OFF_XBAR = 672, OFF_BG = 1184, OFF_CG = 1696, OFF_U = 2208, OFF_GATES = 2720;
constexpr int NSS = 20;
constexpr float ALPHA = 1.41421356237309515f;
constexpr float LN_EPS = 1e-5f, RMS_EPS = 1e-6f;
constexpr float QSCALE = 0.10206207261596577f * 1.4426950408889634f;

enum { I_X = 0, I_META, I_F1G, I_F1U, I_F1D, I_LN1G, I_LN1B, I_WIN, I_QNG, I_WUQ, I_KVNG, I_WUKV, I_WOA, I_CONVW, I_CONVB, I_WOB,
       I_SARE, I_SAIM, I_SLDT, I_SBRE, I_SBIM, I_SCRE, I_SCIM, I_SD, I_WGLU, I_BGLU, I_WOC, I_WO, I_LN2G, I_LN2B, I_F2G, I_F2U, I_F2D, I_LN3G, I_LN3B, N_IN };

constexpr size_t MiB = 1u << 20;
constexpr size_t WS_CTL = 0, CTL_BYTES = 1 * MiB;
constexpr size_t WS_TAB = 1 * MiB;
constexpr size_t TAB_COS = 0, TAB_SIN = 132096, TAB_AB = 264192, TAB_BBR = 296960, TAB_BBI = 559104;
constexpr size_t WS_META = 2 * MiB;
constexpr size_t MT_X = 0, MT_XN = 65536, MT_H = 98304, MT_PROJ = 188416, MT_Q = 278528, MT_GB = 303104, MT_YC = 319488, MT_YG = 335872, MT_SG = 352256, MT_MIX = 450560, MT_SS = 483328;
constexpr size_t WS_SS = 4 * MiB;
constexpr size_t WS_SLOT0 = 6 * MiB, WS_SLOT1 = 18 * MiB;
constexpr size_t WS_XN = 30 * MiB;
constexpr size_t WS_R1 = 62 * MiB;
constexpr size_t WS_Q = 158 * MiB;
constexpr size_t WS_KV = 182 * MiB;
constexpr size_t WS_KR = 215 * MiB;
constexpr size_t WS_GB = 217 * MiB, WS_YC = 233 * MiB, WS_YG = 249 * MiB, WS_END = 265 * MiB;

constexpr int LDS_BYTES = 147456;

struct Args { const float* in[N_IN]; float* out; unsigned char* ws; int st_lo, st_hi; };

__device__ __forceinline__ unsigned f2bf(float f) { unsigned u = __float_as_uint(f); return (u + 0x7fffu + ((u >> 16) & 1u)) >> 16; }
__device__ __forceinline__ unsigned pk2(float lo, float hi) { return f2bf(lo) | (f2bf(hi) << 16); }
__device__ __forceinline__ float bflo(unsigned w) { return __uint_as_float(w << 16); }
__device__ __forceinline__ float bfhi(unsigned w) { return __uint_as_float(w & 0xffff0000u); }
__device__ __forceinline__ float bf2f(bf16_t h) { return __uint_as_float((unsigned)h << 16); }
__device__ __forceinline__ float sigmoidf_(float x) { return 1.0f / (1.0f + __expf(-x)); }
__device__ __forceinline__ float gelu_tanh(float x) { const float z = 0.7978845608028654f * (x + 0.044715f * x * x * x); const float e = __expf(2.0f * z); const float t = 1.0f - 2.0f / (e + 1.0f); return 0.5f * x * (1.0f + t); }
__device__ __forceinline__ float wave_sum(float v) {
#pragma unroll
    for (int o = 1; o < 64; o <<= 1) v += __shfl_xor(v, o);
    return v;
}
__device__ __forceinline__ float wave_max(float v) {
#pragma unroll
    for (int o = 1; o < 64; o <<= 1) v = fmaxf(v, __shfl_xor(v, o));
    return v;
}
__device__ __forceinline__ u32x2 pack4(f32x4 v) { u32x2 w; w.x = pk2(v[0], v[1]); w.y = pk2(v[2], v[3]); return w; }
__device__ __forceinline__ f32x4 unpack4(u32x2 w) { return (f32x4){bflo(w.x), bfhi(w.x), bflo(w.y), bfhi(w.y)}; }

struct EpiSwiglu { bf16_t* H; int ldh;
    __device__ __forceinline__ void pair(int row, int c0, f32x4 g, f32x4 u) const {
        const int hc = (c0 >> 5) * 16 + (c0 & 31); f32x4 h;
#pragma unroll
        for (int i = 0; i < 4; ++i) h[i] = g[i] * sigmoidf_(g[i]) * u[i];
        *(u32x2*)(H + (size_t)row * ldh + hc) = pack4(h); } };
struct EpiResid { const float* Xin; float* Xout; float alpha, s;
    __device__ __forceinline__ void pair(int row, int c0, f32x4 v0, f32x4 v1) const {
        const size_t o = (size_t)row * DM + c0; const f32x4 a = *(const f32x4*)(Xin + o), b = *(const f32x4*)(Xin + o + 16);
        *(f32x4*)(Xout + o) = a * alpha + v0 * s; *(f32x4*)(Xout + o + 16) = b * alpha + v1 * s; } };
struct EpiProjA { bf16_t* P; float* SS;
    __device__ __forceinline__ void pair(int row, int c0, f32x4 v0, f32x4 v1) const {
        const u32x2 w0 = pack4(v0), w1 = pack4(v1);
        *(u32x2*)(P + (size_t)row * PA_N + c0) = w0; *(u32x2*)(P + (size_t)row * PA_N + c0 + 16) = w1;
        if ((c0 >> 5) < NSS) { const f32x4 a = unpack4(w0), b = unpack4(w1);
            float ss = (a[0] * a[0] + a[1] * a[1]) + (a[2] * a[2] + a[3] * a[3]) + (b[0] * b[0] + b[1] * b[1]) + (b[2] * b[2] + b[3] * b[3]);
            ss += __shfl_xor(ss, 16); ss += __shfl_xor(ss, 32);
            if ((threadIdx.x & 63) < 16) SS[(size_t)row * NSS + (c0 >> 5)] = ss; } } };
struct EpiUq { bf16_t* Q; const float* SS; const float* rcos; const float* rsin; int posoff, posmask;
    __device__ __forceinline__ void pair(int row, int c0, f32x4 v0, f32x4 v1) const {
        const f32x4 s0 = *(const f32x4*)(SS + (size_t)row * NSS), s1 = *(const f32x4*)(SS + (size_t)row * NSS + 4), s2 = *(const f32x4*)(SS + (size_t)row * NSS + 8);
        const float ss = ((s0[0] + s0[1]) + (s0[2] + s0[3])) + ((s1[0] + s1[1]) + (s1[2] + s1[3])) + ((s2[0] + s2[1]) + (s2[2] + s2[3]));
        const float sc = rsqrtf(ss * (1.0f / 384.0f) + RMS_EPS) * QSCALE;
        v0 = v0 * sc; v1 = v1 * sc;
        if (c0 >= 512) { const int j = (c0 - 512) & 31; const int pos = posoff + (row & posmask);
            const f32x4 cs = *(const f32x4*)(rcos + pos * 16 + j), sn = *(const f32x4*)(rsin + pos * 16 + j);
            const f32x4 a = v0 * cs - v1 * sn, b = v1 * cs + v0 * sn; v0 = a; v1 = b; }
        *(u32x2*)(Q + (size_t)row * 768 + c0) = pack4(v0); *(u32x2*)(Q + (size_t)row * 768 + c0 + 16) = pack4(v1); } };
struct EpiUkv { bf16_t* KV; const float* SS; int meta;
    __device__ __forceinline__ void pair(int row, int c0, f32x4 v0, f32x4 v1) const {
        const f32x4 s0 = *(const f32x4*)(SS + (size_t)row * NSS + 12), s1 = *(const f32x4*)(SS + (size_t)row * NSS + 16);
        const float ss = ((s0[0] + s0[1]) + (s0[2] + s0[3])) + ((s1[0] + s1[1]) + (s1[2] + s1[3]));
        const float sc = rsqrtf(ss * (1.0f / 256.0f) + RMS_EPS);
        const u32x2 w0 = pack4(v0 * sc), w1 = pack4(v1 * sc);
        if (!meta) { const size_t dr = (size_t)row + 64 * (row >> 11) + 16; *(u32x2*)(KV + dr * 1024 + c0) = w0; *(u32x2*)(KV + dr * 1024 + c0 + 16) = w1; }
        else { for (int b = 0; b < NB; ++b) { const size_t dr = (size_t)b * LPAD + row; *(u32x2*)(KV + dr * 1024 + c0) = w0; *(u32x2*)(KV + dr * 1024 + c0 + 16) = w1; } } } };
struct EpiSig { bf16_t* SG;
    __device__ __forceinline__ void pair(int row, int c0, f32x4 v0, f32x4 v1) const {
        f32x4 a, b;
#pragma unroll
        for (int i = 0; i < 4; ++i) { a[i] = sigmoidf_(v0[i]); b[i] = sigmoidf_(v1[i]); }
        *(u32x2*)(SG + (size_t)row * 3072 + c0) = pack4(a); *(u32x2*)(SG + (size_t)row * 3072 + c0 + 16) = pack4(b); } };
struct EpiGlu { bf16_t* YG; const bf16_t* YC; const float* bglu;
    __device__ __forceinline__ void pair(int row, int c0, f32x4 v0, f32x4 v1) const {
        const f32x4 y0 = unpack4(*(const u32x2*)(YC + (size_t)row * 512 + c0)), y1 = unpack4(*(const u32x2*)(YC + (size_t)row * 512 + c0 + 16));
        const f32x4 b0 = *(const f32x4*)(bglu + c0), b1 = *(const f32x4*)(bglu + c0 + 16); f32x4 a, b;
#pragma unroll
        for (int i = 0; i < 4; ++i) { a[i] = y0[i] * sigmoidf_(v0[i] + b0[i]); b[i] = y1[i] * sigmoidf_(v1[i] + b1[i]); }
        *(u32x2*)(YG + (size_t)row * 512 + c0) = pack4(a); *(u32x2*)(YG + (size_t)row * 512 + c0 + 16) = pack4(b); } };
struct EpiMerge { bf16_t* MX; const bf16_t* SG; int gi; int first;
    __device__ __forceinline__ void pair(int row, int c0, f32x4 v0, f32x4 v1) const {
        const bf16_t* sg = SG + (size_t)row * 3072 + gi * 1024 + c0; bf16_t* mx = MX + (size_t)row * DM + c0;
        f32x4 a = unpack4(*(const u32x2*)sg) * v0, b = unpack4(*(const u32x2*)(sg + 16)) * v1;
        if (!first) { a = a + unpack4(*(const u32x2*)mx); b = b + unpack4(*(const u32x2*)(mx + 16)); }
        *(u32x2*)mx = pack4(a); *(u32x2*)(mx + 16) = pack4(b); } };

template <class Epi>
__device__ __forceinline__ void gemm_simple(const bf16_t* A, int lda, const bf16_t* Bt, int K, int Mr, int Nc, const Epi& E) {
    const int lane = threadIdx.x & 63, wid = threadIdx.x >> 6, fr = lane & 15, fq = lane >> 4;
    const int gw = blockIdx.x * 8 + wid, NGW = gridDim.x * 8, nct = Nc / 64, nit = (Mr / 32) * nct;
    for (int it = gw; it < nit; it += NGW) {
        const int rt = it / nct, ct = it % nct;
        f32x4 acc[2][4];
#pragma unroll
        for (int m = 0; m < 2; ++m)
#pragma unroll
            for (int n = 0; n < 4; ++n) acc[m][n] = (f32x4){0.f, 0.f, 0.f, 0.f};
        const bf16_t* ap = A + (size_t)(rt * 32 + fr) * lda + 8 * fq;
        const bf16_t* bp = Bt + (size_t)(ct * 64 + fr) * K + 8 * fq;
        for (int k0 = 0; k0 < K; k0 += 32) {
            bf16x8 a[2], b[4];
#pragma unroll
            for (int m = 0; m < 2; ++m) a[m] = *(const bf16x8*)(ap + (size_t)m * 16 * lda + k0);
#pragma unroll
            for (int n = 0; n < 4; ++n) b[n] = *(const bf16x8*)(bp + (size_t)n * 16 * K + k0);
#pragma unroll
            for (int m = 0; m < 2; ++m)
#pragma unroll
                for (int n = 0; n < 4; ++n) acc[m][n] = __builtin_amdgcn_mfma_f32_16x16x32_bf16(b[n], a[m], acc[m][n], 0, 0, 0);
        }
#pragma unroll
        for (int m = 0; m < 2; ++m)
#pragma unroll
            for (int np = 0; np < 2; ++np) E.pair(rt * 32 + m * 16 + fr, ct * 64 + np * 32 + 4 * fq, acc[m][2 * np], acc[m][2 * np + 1]);
    }
}
template <class Epi>
__device__ __forceinline__ void gemm_meta(const bf16_t* A, int lda, const bf16_t* Bt, int K, int Nc, const Epi& E, float* red) {
    const int lane = threadIdx.x & 63, wid = threadIdx.x >> 6, fr = lane & 15, fq = lane >> 4;
    for (int cg = (int)blockIdx.x; cg < Nc / 32; cg += (int)gridDim.x) {
        f32x4 a0 = (f32x4){0.f, 0.f, 0.f, 0.f}, a1 = a0;
        const bf16_t* ap = A + (size_t)fr * lda + 8 * fq;
        const bf16_t* bp = Bt + (size_t)(cg * 32 + fr) * K + 8 * fq;
        for (int ks = wid; ks < K / 32; ks += 8) {
            const bf16x8 a = *(const bf16x8*)(ap + ks * 32);
            const bf16x8 b0 = *(const bf16x8*)(bp + ks * 32), b1 = *(const bf16x8*)(bp + (size_t)16 * K + ks * 32);
            a0 = __builtin_amdgcn_mfma_f32_16x16x32_bf16(b0, a, a0, 0, 0, 0);
            a1 = __builtin_amdgcn_mfma_f32_16x16x32_bf16(b1, a, a1, 0, 0, 0);
        }
        *(f32x4*)(red + (wid * 64 + lane) * 8) = a0; *(f32x4*)(red + (wid * 64 + lane) * 8 + 4) = a1;
        __syncthreads();
        if (wid == 0) {
            f32x4 s0 = (f32x4){0.f, 0.f, 0.f, 0.f}, s1 = s0;
#pragma unroll
            for (int w = 0; w < 8; ++w) { s0 = s0 + *(const f32x4*)(red + (w * 64 + lane) * 8); s1 = s1 + *(const f32x4*)(red + (w * 64 + lane) * 8 + 4); }
            E.pair(fr, cg * 32 + 4 * fq, s0, s1);
        }
        __syncthreads();
    }
}

struct WDesc { const float* src0; const float* src1; int srcN; int K; bf16_t* dst; int rows; int kind; int coff; int nvalid; const float* scale; };
__device__ __forceinline__ void cvt_weight(const WDesc& d, float* scr_all) {
    const int lane = threadIdx.x & 63, wid = threadIdx.x >> 6;
    float* scr = scr_all + wid * (64 * 33);
    const int gw = blockIdx.x * 8 + wid, NGW = gridDim.x * 8, nblk = d.rows / 32, nit = (d.K / 64) * nblk;
    for (int it = gw; it < nit; it += NGW) {
        const int kb = it / nblk, nb = it % nblk, k0 = 64 * kb, n0 = 32 * nb;
        const int r = n0 + (lane & 31);
        const float* src = d.src0; int col = 0; bool valid = true;
        if (d.kind == 0) { valid = r < d.nvalid; col = d.coff + r; }
        else if (d.kind == 1) { const int q = r >> 5, w = r & 31; src = (w < 16) ? d.src0 : d.src1; col = 16 * q + (w & 15); }
        else { if (r < 512) col = (r >> 6) * 96 + (r & 63); else col = ((r - 512) >> 5) * 96 + 64 + ((r - 512) & 31); }
#pragma unroll 8
        for (int i = 0; i < 32; ++i) { const int kk = 2 * i + (lane >> 5);
            float v = valid ? src[(size_t)(k0 + kk) * d.srcN + col] : 0.f; if (d.scale) v *= d.scale[k0 + kk];
            scr[kk * 33 + (lane & 31)] = v; }
        const int c8 = lane & 7;
#pragma unroll
        for (int j = 0; j < 4; ++j) { const int n = (lane >> 3) + 8 * j; const float* s = scr + (8 * c8) * 33 + n;
            u32x4 o; o.x = pk2(s[0], s[33]); o.y = pk2(s[66], s[99]); o.z = pk2(s[132], s[165]); o.w = pk2(s[198], s[231]);
            *(u32x4*)(d.dst + (size_t)(n0 + n) * d.K + k0 + 8 * c8) = o; }
    }
}
__device__ __forceinline__ bf16_t* slot_ptr(const Args& a, int gp) { return (bf16_t*)(a.ws + ((gp & 1) ? WS_SLOT1 : WS_SLOT0)); }
__device__ __forceinline__ void convert_phase(const Args& a, int l, int p, float* scr) {
    if (l > 1) return;
    bf16_t* S = slot_ptr(a, 9 * l + p);
    WDesc d; d.src1 = nullptr; d.kind = 0; d.coff = 0; d.scale = nullptr;
    if (p == 1 || p == 8) { const int ig = (p == 1) ? I_F1G : I_F2G;
        d.src0 = a.in[ig] + (size_t)l * DM * DFF; d.src1 = a.in[ig + 1] + (size_t)l * DM * DFF; d.srcN = DFF; d.K = DM; d.dst = S; d.rows = NGU; d.kind = 1; d.nvalid = NGU; cvt_weight(d, scr); }
    else if (p == 2 || p == 9) { const int id = (p == 2) ? I_F1D : I_F2D;
        d.src0 = a.in[id] + (size_t)l * DFF * DM; d.srcN = DM; d.K = DFF; d.dst = S; d.rows = DM; d.nvalid = DM; cvt_weight(d, scr); }
    else if (p == 3) { d.src0 = a.in[I_WIN] + (size_t)l * DM * DIN; d.srcN = DIN; d.K = DM; d.dst = S; d.rows = PA_N; d.nvalid = OFF_GATES; cvt_weight(d, scr); }
    else if (p == 4) {
        d.src0 = a.in[I_WUQ] + (size_t)l * 384 * 768; d.srcN = 768; d.K = 384; d.dst = S; d.rows = 768; d.kind = 2; d.nvalid = 768; d.scale = a.in[I_QNG] + l * 384; cvt_weight(d, scr);
        d.src0 = a.in[I_WUKV] + (size_t)l * 256 * 1024; d.srcN = 1024; d.K = 256; d.dst = S + (1 * MiB) / 2; d.rows = 1024; d.kind = 0; d.nvalid = 1024; d.scale = a.in[I_KVNG] + l * 256; cvt_weight(d, scr); }
    else if (p == 5) {
        d.src0 = a.in[I_WIN] + (size_t)l * DM * DIN; d.srcN = DIN; d.K = DM; d.dst = S; d.rows = 3072; d.coff = OFF_GATES; d.nvalid = 3072; cvt_weight(d, scr);
        d.src0 = a.in[I_WGLU] + (size_t)l * 512 * 512; d.srcN = 512; d.K = 512; d.dst = S + (8 * MiB) / 2; d.rows = 512; d.coff = 0; d.nvalid = 512; cvt_weight(d, scr); }
    else if (p == 6) {
        d.srcN = DM; d.K = 512; d.rows = DM; d.nvalid = DM;
        d.src0 = a.in[I_WOA] + (size_t)l * 512 * DM; d.dst = S; cvt_weight(d, scr);
        d.src0 = a.in[I_WOB] + (size_t)l * 512 * DM; d.dst = S + (1 * MiB) / 2; cvt_weight(d, scr);
        d.src0 = a.in[I_WOC] + (size_t)l * 512 * DM; d.dst = S + (2 * MiB) / 2; cvt_weight(d, scr); }
    else if (p == 7) { d.src0 = a.in[I_WO] + (size_t)l * DM * DM; d.srcN = DM; d.K = DM; d.dst = S; d.rows = DM; d.nvalid = DM; cvt_weight(d, scr); }
}
__device__ __forceinline__ void convert_next(const Args& a, int l, int p, float* scr) { if (p == 9) convert_phase(a, l + 1, 1, scr); else convert_phase(a, l, p + 1, scr); }

__device__ __forceinline__ void ln_row(float* xrow, bf16_t* orow, const float* g, const float* b, int lane) {
    f32x4 v[4]; float s = 0.f;
#pragma unroll
    for (int j = 0; j < 4; ++j) { v[j] = *(const f32x4*)(xrow + 4 * lane + 256 * j); s += (v[j][0] + v[j][1]) + (v[j][2] + v[j][3]); }
    const float mean = wave_sum(s) * (1.f / DM); float s2 = 0.f;
#pragma unroll
    for (int j = 0; j < 4; ++j) { v[j] = v[j] - mean; s2 += (v[j][0] * v[j][0] + v[j][1] * v[j][1]) + (v[j][2] * v[j][2] + v[j][3] * v[j][3]); }
    const float rstd = rsqrtf(wave_sum(s2) * (1.f / DM) + LN_EPS);
#pragma unroll
    for (int j = 0; j < 4; ++j) { const f32x4 gg = *(const f32x4*)(g + 4 * lane + 256 * j), bb = *(const f32x4*)(b + 4 * lane + 256 * j);
        const f32x4 o = v[j] * rstd * gg + bb; *(f32x4*)(xrow + 4 * lane + 256 * j) = o; *(u32x2*)(orow + 4 * lane + 256 * j) = pack4(o); }
}
__device__ __forceinline__ void stage_ln(const Args& a, const float* g, const float* b) {
    const int lane = threadIdx.x & 63, gw = blockIdx.x * 8 + (threadIdx.x >> 6), NGW = gridDim.x * 8;
    float* Xm = (float*)(a.ws + WS_META + MT_X); bf16_t* XNm = (bf16_t*)(a.ws + WS_META + MT_XN); bf16_t* XN = (bf16_t*)(a.ws + WS_XN);
    for (int r = gw; r < MROWS + NMETA; r += NGW) {
        if (r < MROWS) ln_row(a.out + (size_t)r * DM, XN + (size_t)r * DM, g, b, lane);
        else ln_row(Xm + (size_t)(r - MROWS) * DM, XNm + (size_t)(r - MROWS) * DM, g, b, lane);
    }
}
__device__ __forceinline__ void stage_prologue(const Args& a, float* scr) {
    const int tid = threadIdx.x, gt = blockIdx.x * 512 + tid, NGT = gridDim.x * 512;
    bf16_t* XN = (bf16_t*)(a.ws + WS_XN); float* Xm = (float*)(a.ws + WS_META + MT_X); bf16_t* XNm = (bf16_t*)(a.ws + WS_META + MT_XN);
    const float* x = a.in[I_X];
    for (size_t i = gt; i < (size_t)MROWS * DM / 8; i += NGT) { const f32x4 p = *(const f32x4*)(x + i * 8), q = *(const f32x4*)(x + i * 8 + 4);
        u32x4 o; o.x = pk2(p[0], p[1]); o.y = pk2(p[2], p[3]); o.z = pk2(q[0], q[1]); o.w = pk2(q[2], q[3]); *(u32x4*)(XN + i * 8) = o; }
    for (int i = gt; i < NMETA * DM; i += NGT) { const float v = a.in[I_META][i]; Xm[i] = v; XNm[i] = (bf16_t)f2bf(v); }
    float* rc = (float*)(a.ws + WS_TAB + TAB_COS); float* rs = (float*)(a.ws + WS_TAB + TAB_SIN);
    for (int i = gt; i < (SEQ + NMETA) * 16; i += NGT) { const int pos = i >> 4, j = i & 15; const double inv = pow(10000.0, -(double)j / 16.0), ang = (double)pos * inv; rc[i] = (float)cos(ang); rs[i] = (float)sin(ang); }
    float* AB = (float*)(a.ws + WS_TAB + TAB_AB); float* BBR = (float*)(a.ws + WS_TAB + TAB_BBR); float* BBI = (float*)(a.ws + WS_TAB + TAB_BBI);
    for (int i = gt; i < 2 * 32 * 64; i += NGT) {
        const int lg = i >> 6; const double are = a.in[I_SARE][i], aim = a.in[I_SAIM][i], dt = exp((double)a.in[I_SLDT][lg]);
        const double mag = exp(dt * are), abr = mag * cos(dt * aim), abi = mag * sin(dt * aim), den = are * are + aim * aim, nr = abr - 1.0, ni = abi;
        const double cr = (nr * are + ni * aim) / den, ci = (ni * are - nr * aim) / den;
        AB[2 * i] = (float)abr; AB[2 * i + 1] = (float)abi;
        for (int h = 0; h < 16; ++h) { const double br = a.in[I_SBRE][(size_t)i * 16 + h], bi = a.in[I_SBIM][(size_t)i * 16 + h];
            BBR[(size_t)i * 16 + h] = (float)(cr * br - ci * bi); BBI[(size_t)i * 16 + h] = (float)(cr * bi + ci * br); } }
    convert_phase(a, 0, 1, scr);
}
__device__ __forceinline__ void stage_krope_pad(const Args& a) {
    const int gt = blockIdx.x * 512 + threadIdx.x, NGT = gridDim.x * 512;
    const bf16_t* PA = (const bf16_t*)(a.ws + WS_R1); const bf16_t* PM = (const bf16_t*)(a.ws + WS_META + MT_PROJ);
    bf16_t* KR = (bf16_t*)(a.ws + WS_KR); bf16_t* KV = (bf16_t*)(a.ws + WS_KV);
    const float* rc = (const float*)(a.ws + WS_TAB + TAB_COS); const float* rs = (const float*)(a.ws + WS_TAB + TAB_SIN);
    for (int i = gt; i < (MROWS + NMETA) * 16; i += NGT) { const int r = i >> 4, j = i & 15;
        if (r < MROWS) { const int pos = 16 + (r & 2047); const bf16_t* p = PA + (size_t)r * PA_N + OFF_KR; const float x1 = bf2f(p[j]), x2 = bf2f(p[j + 16]), c = rc[pos * 16 + j], s = rs[pos * 16 + j];
            bf16_t* o = KR + ((size_t)r + 64 * (r >> 11) + 16) * 32; o[j] = (bf16_t)f2bf(x1 * c - x2 * s); o[j + 16] = (bf16_t)f2bf(x2 * c + x1 * s); }
        else { const int pos = r - MROWS; const bf16_t* p = PM + (size_t)pos * PA_N + OFF_KR; const float x1 = bf2f(p[j]), x2 = bf2f(p[j + 16]), c = rc[pos * 16 + j], s = rs[pos * 16 + j];
            const bf16_t o1 = (bf16_t)f2bf(x1 * c - x2 * s), o2 = (bf16_t)f2bf(x2 * c + x1 * s);
            for (int b = 0; b < NB; ++b) { bf16_t* o = KR + ((size_t)b * LPAD + pos) * 32; o[j] = o1; o[j + 16] = o2; } } }
    for (int i = gt; i < NB * 48 * 128; i += NGT) { const int b = i / (48 * 128), rem = i % (48 * 128), rr = rem >> 7, c = rem & 127; *(u32x4*)(KV + ((size_t)b * LPAD + 2064 + rr) * 1024 + c * 8) = (u32x4){0u, 0u, 0u, 0u}; }
    for (int i = gt; i < NB * 48 * 4; i += NGT) { const int b = i / (48 * 4), rem = i % (48 * 4), rr = rem >> 2, c = rem & 3; *(u32x4*)(KR + ((size_t)b * LPAD + 2064 + rr) * 32 + c * 8) = (u32x4){0u, 0u, 0u, 0u}; }
}
__device__ __forceinline__ void stage_conv(const Args& a, int l) {
    const int gt = blockIdx.x * 512 + threadIdx.x, NGT = gridDim.x * 512;
    const bf16_t* PA = (const bf16_t*)(a.ws + WS_R1); const bf16_t* PM = (const bf16_t*)(a.ws + WS_META + MT_PROJ);
    bf16_t* GB = (bf16_t*)(a.ws + WS_GB); bf16_t* GBm = (bf16_t*)(a.ws + WS_META + MT_GB);
    const float* cw = a.in[I_CONVW] + l * 3 * 512; const float* cb = a.in[I_CONVB] + l * 512;
    for (int i = gt; i < (MROWS + NMETA) * 64; i += NGT) { const int r = i >> 6, c = (i & 63) * 8;
        const bf16_t *cur, *p1, *p2; bf16_t* dst;
        if (r < MROWS) { const int t = r & 2047; cur = PA + (size_t)r * PA_N; p1 = (t >= 1) ? cur - PA_N : PM + 15 * PA_N; p2 = (t >= 2) ? cur - 2 * PA_N : (t == 1 ? PM + 15 * PA_N : PM + 14 * PA_N); dst = GB + (size_t)r * 512 + c; }
        else { const int t = r - MROWS; cur = PM + (size_t)t * PA_N; p1 = (t >= 1) ? cur - PA_N : nullptr; p2 = (t >= 2) ? cur - 2 * PA_N : nullptr; dst = GBm + (size_t)t * 512 + c; }
        const u32x4 xb0 = *(const u32x4*)(cur + OFF_XBAR + c), cg0 = *(const u32x4*)(cur + OFF_CG + c), bg = *(const u32x4*)(cur + OFF_BG + c);
        u32x4 xb1 = (u32x4){0u, 0u, 0u, 0u}, cg1 = xb1, xb2 = xb1, cg2 = xb1;
        if (p1) { xb1 = *(const u32x4*)(p1 + OFF_XBAR + c); cg1 = *(const u32x4*)(p1 + OFF_CG + c); }
        if (p2) { xb2 = *(const u32x4*)(p2 + OFF_XBAR + c); cg2 = *(const u32x4*)(p2 + OFF_CG + c); }
        u32x4 o;
#pragma unroll
        for (int q = 0; q < 4; ++q) {
            const int ce = c + 2 * q;
            const float u0l = bflo(cg0[q]) * bflo(xb0[q]), u0h = bfhi(cg0[q]) * bfhi(xb0[q]);
            const float u1l = bflo(cg1[q]) * bflo(xb1[q]), u1h = bfhi(cg1[q]) * bfhi(xb1[q]);
            const float u2l = bflo(cg2[q]) * bflo(xb2[q]), u2h = bfhi(cg2[q]) * bfhi(xb2[q]);
            const float yl = cb[ce] + cw[ce] * u2l + cw[512 + ce] * u1l + cw[1024 + ce] * u0l;
            const float yh = cb[ce + 1] + cw[ce + 1] * u2h + cw[512 + ce + 1] * u1h + cw[1024 + ce + 1] * u0h;
            o[q] = pk2(bflo(bg[q]) * yl, bfhi(bg[q]) * yh); }
        *(u32x4*)dst = o; }
}
__device__ __forceinline__ void stage_s5(const Args& a, int l, unsigned char* lds) {
    float* E = (float*)lds; float* Cp = (float*)(lds + 4096); float* Xs = (float*)(lds + 12288);
    const int tid = threadIdx.x, lane = tid & 63, wid = tid >> 6;
    const bf16_t* PA = (const bf16_t*)(a.ws + WS_R1); const bf16_t* PM = (const bf16_t*)(a.ws + WS_META + MT_PROJ);
    bf16_t* YC = (bf16_t*)(a.ws + WS_YC); bf16_t* YCm = (bf16_t*)(a.ws + WS_META + MT_YC);
    const float* AB = (const float*)(a.ws + WS_TAB + TAB_AB); const float* BBR = (const float*)(a.ws + WS_TAB + TAB_BBR); const float* BBI = (const float*)(a.ws + WS_TAB + TAB_BBI);
    float* xs = Xs + wid * (16 * 129);
    for (int it = (int)blockIdx.x; it < NB * 32; it += (int)gridDim.x) {
        const int b = it >> 5, g = it & 31, pi_ = (l * 32 + g) * 64 + lane;
        const float abr = AB[2 * pi_], abi = AB[2 * pi_ + 1];
        float br[16], bi[16];
#pragma unroll
        for (int h = 0; h < 16; ++h) { br[h] = BBR[(size_t)pi_ * 16 + h]; bi[h] = BBI[(size_t)pi_ * 16 + h]; }
        __syncthreads();
        for (int idx = tid; idx < 2048; idx += 512) { const int k = idx >> 4, h = idx & 15;
            Cp[idx] = (k < 64) ? a.in[I_SCRE][((size_t)(l * 32 + g) * 16 + h) * 64 + k] : -a.in[I_SCIM][((size_t)(l * 32 + g) * 16 + h) * 64 + (k - 64)]; }
        const int uoff = OFF_U + 16 * g;
        const bf16_t* ubase = PA + ((size_t)b * SEQ + 256 * wid) * PA_N + uoff;
        float xr = 0.f, xi = 0.f;
#define S5_STEP(UP) do { const u32x4 w0_ = *(const u32x4*)(UP), w1_ = *(const u32x4*)((UP) + 8); float bur = 0.f, bui = 0.f; \
            _Pragma("unroll") for (int q = 0; q < 4; ++q) { const float ul = bflo(w0_[q]), uh = bfhi(w0_[q]), vl = bflo(w1_[q]), vh = bfhi(w1_[q]); \
                bur += br[2 * q] * ul + br[2 * q + 1] * uh + br[8 + 2 * q] * vl + br[8 + 2 * q + 1] * vh; bui += bi[2 * q] * ul + bi[2 * q + 1] * uh + bi[8 + 2 * q] * vl + bi[8 + 2 * q + 1] * vh; } \
            const float nxr = abr * xr - abi * xi + bur, nxi = abr * xi + abi * xr + bui; xr = nxr; xi = nxi; } while (0)
        if (wid == 0) for (int r = 0; r < NMETA; ++r) S5_STEP(PM + (size_t)r * PA_N + uoff);
        for (int t = 0; t < 256; ++t) S5_STEP(ubase + (size_t)t * PA_N);
        E[(wid * 64 + lane) * 2] = xr; E[(wid * 64 + lane) * 2 + 1] = xi;
        __syncthreads();
        float pr = abr, pim = abi;
#pragma unroll
        for (int s = 0; s < 8; ++s) { const float nr = pr * pr - pim * pim, ni = 2.f * pr * pim; pr = nr; pim = ni; }
        xr = 0.f; xi = 0.f;
        for (int v = 0; v < wid; ++v) { const float er = E[(v * 64 + lane) * 2], ei = E[(v * 64 + lane) * 2 + 1]; const float nr = pr * xr - pim * xi + er, ni = pr * xi + pim * xr + ei; xr = nr; xi = ni; }
        const int tl = lane >> 2, hq = lane & 3;
        const f32x4 dv = *(const f32x4*)(a.in[I_SD] + (size_t)(l * 32 + g) * 16 + 4 * hq);
        for (int sc = (wid == 0 ? -1 : 0); sc < 16; ++sc) {
            const bf16_t* ub = (sc < 0) ? PM + uoff : ubase + (size_t)(16 * sc) * PA_N;
            for (int t = 0; t < 16; ++t) { S5_STEP(ub + (size_t)t * PA_N); xs[t * 129 + lane] = xr; xs[t * 129 + 64 + lane] = xi; }
            f32x4 acc = (f32x4){0.f, 0.f, 0.f, 0.f};
#pragma unroll 8
            for (int k = 0; k < 128; ++k) { const float xv = xs[tl * 129 + k]; const f32x4 cv = *(const f32x4*)(Cp + k * 16 + 4 * hq); acc = acc + cv * xv; }
            const f32x4 uv = unpack4(*(const u32x2*)(ub + (size_t)tl * PA_N + 4 * hq));
            f32x4 y = acc + dv * uv;
#pragma unroll
            for (int i = 0; i < 4; ++i) y[i] = gelu_tanh(y[i]);
            if (sc >= 0) *(u32x2*)(YC + ((size_t)b * SEQ + 256 * wid + 16 * sc + tl) * 512 + 16 * g + 4 * hq) = pack4(y);
            else if (b == 0) *(u32x2*)(YCm + (size_t)tl * 512 + 16 * g + 4 * hq) = pack4(y);
        }
#undef S5_STEP
    }
}
__device__ __forceinline__ void stage_attn_simple(const Args& a) {
    const int lane = threadIdx.x & 63, gw = blockIdx.x * 8 + (threadIdx.x >> 6), NGW = gridDim.x * 8;
    const bf16_t* KV = (const bf16_t*)(a.ws + WS_KV); const bf16_t* KR = (const bf16_t*)(a.ws + WS_KR);
    bf16_t* Q = (bf16_t*)(a.ws + WS_Q); bf16_t* Qm = (bf16_t*)(a.ws + WS_META + MT_Q);
    constexpr int NMAIN = MROWS * 8;
    for (int it = gw; it < NMAIN + NMETA * 8; it += NGW) {
        int h, pos; bf16_t* qp; size_t kvb;
        if (it < NMAIN) { h = it & 7; const int r = it >> 3; pos = 16 + (r & 2047); qp = Q + (size_t)r * 768; kvb = (size_t)(r >> 11) * LPAD; }
        else { const int j = it - NMAIN; h = j & 7; const int r = j >> 3; pos = r; qp = Qm + (size_t)r * 768; kvb = 0; }
        const float qa = bf2f(qp[h * 64 + lane]); const float qb = bf2f(qp[512 + h * 32 + (lane & 31)]);
        float m = -INFINITY, lsum = 0.f, o = 0.f;
        for (int kc = 0; kc * 64 <= pos; ++kc) {
            const int p = kc * 64 + lane; const bool valid = p <= pos;
            const bf16_t* kp = KV + (kvb + p) * 1024 + h * 128; const bf16_t* rp = KR + (kvb + p) * 32;
            float s = 0.f;
#pragma unroll
            for (int c = 0; c < 8; ++c) { const u32x4 w = *(const u32x4*)(kp + c * 8);
#pragma unroll
                for (int q = 0; q < 4; ++q) { s += __shfl(qa, c * 8 + 2 * q) * bflo(w[q]); s += __shfl(qa, c * 8 + 2 * q + 1) * bfhi(w[q]); } }
#pragma unroll
            for (int c = 0; c < 4; ++c) { const u32x4 w = *(const u32x4*)(rp + c * 8);
#pragma unroll
                for (int q = 0; q < 4; ++q) { s += __shfl(qb, c * 8 + 2 * q) * bflo(w[q]); s += __shfl(qb, c * 8 + 2 * q + 1) * bfhi(w[q]); } }
            s = valid ? s : -INFINITY;
            const float mn = fmaxf(m, wave_max(s)); const float alpha = exp2f(m - mn); const float pj = valid ? exp2f(s - mn) : 0.f;
            lsum = lsum * alpha + wave_sum(pj); o *= alpha; m = mn;
            const int nj = min(64, pos + 1 - kc * 64);
            const bf16_t* vp = KV + (kvb + kc * 64) * 1024 + h * 128 + 64 + lane;
            for (int j = 0; j < nj; ++j) o += __shfl(pj, j) * bf2f(vp[(size_t)j * 1024]);
        }
        qp[h * 64 + lane] = (bf16_t)f2bf(o / lsum);
    }
}

constexpr int N_STAGES = 25;
__device__ __forceinline__ void run_stage(const Args& a, int st, unsigned char* lds) {
    float* scr = (float*)lds;
    unsigned char* ws = a.ws;
    bf16_t* XN = (bf16_t*)(ws + WS_XN); bf16_t* R1 = (bf16_t*)(ws + WS_R1); bf16_t* Q = (bf16_t*)(ws + WS_Q); bf16_t* KV = (bf16_t*)(ws + WS_KV);
    bf16_t* GB = (bf16_t*)(ws + WS_GB); bf16_t* YC = (bf16_t*)(ws + WS_YC); bf16_t* YG = (bf16_t*)(ws + WS_YG); float* SS = (float*)(ws + WS_SS);
    unsigned char* mt = ws + WS_META;
    float* Xm = (float*)(mt + MT_X); bf16_t* XNm = (bf16_t*)(mt + MT_XN); bf16_t* Hm = (bf16_t*)(mt + MT_H); bf16_t* PM = (bf16_t*)(mt + MT_PROJ); bf16_t* Qm = (bf16_t*)(mt + MT_Q);
    bf16_t* GBm = (bf16_t*)(mt + MT_GB); bf16_t* YCm = (bf16_t*)(mt + MT_YC); bf16_t* YGm = (bf16_t*)(mt + MT_YG); bf16_t* SGm = (bf16_t*)(mt + MT_SG); bf16_t* MXm = (bf16_t*)(mt + MT_MIX); float* SSm = (float*)(mt + MT_SS);
    const float* rc = (const float*)(ws + WS_TAB + TAB_COS); const float* rs = (const float*)(ws + WS_TAB + TAB_SIN);
    if (st == 0) { stage_prologue(a, scr); return; }
    const int l = (st - 1) / 12, s = (st - 1) % 12;
    const float* xin = (l == 0) ? a.in[I_X] : a.out;
    if (s == 0 || s == 9) {
        const int p = (s == 0) ? 1 : 8; const bf16_t* W = slot_ptr(a, 9 * l + p);
        gemm_simple(XN, DM, W, DM, MROWS, NGU, EpiSwiglu{R1, DFF});
        gemm_meta(XNm, DM, W, DM, NGU, EpiSwiglu{Hm, DFF}, scr);
        convert_next(a, l, p, scr);
    } else if (s == 1 || s == 10) {
        const int p = (s == 1) ? 2 : 9; const bf16_t* W = slot_ptr(a, 9 * l + p);
        const float* xi_ = (s == 1) ? xin : a.out;
        gemm_simple(R1, DFF, W, DFF, MROWS, DM, EpiResid{xi_, a.out, ALPHA, 0.5f});
        gemm_meta(Hm, DFF, W, DFF, DM, EpiResid{Xm, Xm, ALPHA, 0.5f}, scr);
        convert_next(a, l, p, scr);
    } else if (s == 2) { stage_ln(a, a.in[I_LN1G] + l * DM, a.in[I_LN1B] + l * DM);
    } else if (s == 8) { stage_ln(a, a.in[I_LN2G] + l * DM, a.in[I_LN2B] + l * DM);
    } else if (s == 11) { stage_ln(a, a.in[I_LN3G] + l * DM, a.in[I_LN3B] + l * DM);
    } else if (s == 3) {
        const bf16_t* W = slot_ptr(a, 9 * l + 3);
        gemm_simple(XN, DM, W, DM, MROWS, PA_N, EpiProjA{R1, SS});
        gemm_meta(XNm, DM, W, DM, PA_N, EpiProjA{PM, SSm}, scr);
        convert_next(a, l, 3, scr);
    } else if (s == 4) {
        const bf16_t* W = slot_ptr(a, 9 * l + 4);
        gemm_simple(R1, PA_N, W, 384, MROWS, 768, EpiUq{Q, SS, rc, rs, 16, 2047});
        gemm_meta(PM, PA_N, W, 384, 768, EpiUq{Qm, SSm, rc, rs, 0, 15}, scr);
        gemm_simple(R1 + OFF_CKV, PA_N, W + (1 * MiB) / 2, 256, MROWS, 1024, EpiUkv{KV, SS, 0});
        gemm_meta(PM + OFF_CKV, PA_N, W + (1 * MiB) / 2, 256, 1024, EpiUkv{KV, SSm, 1}, scr);
        stage_krope_pad(a);
        stage_conv(a, l);
        __syncthreads();
        stage_s5(a, l, lds);
        __syncthreads();
        convert_next(a, l, 4, scr);
    } else if (s == 5) {
        const bf16_t* W = slot_ptr(a, 9 * l + 5);
        stage_attn_simple(a);
        gemm_simple(YC, 512, W + (8 * MiB) / 2, 512, MROWS, 512, EpiGlu{YG, YC, a.in[I_BGLU] + l * 512});
        gemm_meta(YCm, 512, W + (8 * MiB) / 2, 512, 512, EpiGlu{YGm, YCm, a.in[I_BGLU] + l * 512}, scr);
        gemm_simple(XN, DM, W, DM, MROWS, 3072, EpiSig{R1});
        gemm_meta(XNm, DM, W, DM, 3072, EpiSig{SGm}, scr);
        convert_next(a, l, 5, scr);
    } else if (s == 6) {
        const bf16_t* W = slot_ptr(a, 9 * l + 6);
        gemm_simple(Q, 768, W, 512, MROWS, DM, EpiMerge{KV, R1, 0, 1});
        gemm_simple(GB, 512, W + (1 * MiB) / 2, 512, MROWS, DM, EpiMerge{KV, R1, 1, 0});
        gemm_simple(YG, 512, W + (2 * MiB) / 2, 512, MROWS, DM, EpiMerge{KV, R1, 2, 0});
        gemm_meta(Qm, 768, W, 512, DM, EpiMerge{MXm, SGm, 0, 1}, scr);
        gemm_meta(GBm, 512, W + (1 * MiB) / 2, 512, DM, EpiMerge{MXm, SGm, 1, 0}, scr);
        gemm_meta(YGm, 512, W + (2 * MiB) / 2, 512, DM, EpiMerge{MXm, SGm, 2, 0}, scr);
        convert_next(a, l, 6, scr);
    } else if (s == 7) {
        const bf16_t* W = slot_ptr(a, 9 * l + 7);
        gemm_simple(KV, DM, W, DM, MROWS, DM, EpiResid{a.out, a.out, ALPHA, 1.0f});
        gemm_meta(MXm, DM, W, DM, DM, EpiResid{Xm, Xm, ALPHA, 1.0f}, scr);
        convert_next(a, l, 7, scr);
    }
}

__global__ void __launch_bounds__(512, 2) mk_fwd(Args a) {
    extern __shared__ __attribute__((aligned(16))) unsigned char lds[];
    run_stage(a, a.st_lo, lds);
}

extern "C" void kernel_launch(void* const* d_in, const int* in_sizes, int n_in, void* d_out, int out_size, void* d_ws, size_t ws_size, hipStream_t stream) {
    static int grid = 0;
    if (grid == 0) {
        if (n_in != N_IN || out_size != MROWS * DM || ws_size < WS_END) { fprintf(stderr, "kernel_launch: unexpected shapes (n_in %d, out %d, ws %zu)\n", n_in, out_size, ws_size); grid = -1; return; }
        int dev = 0, cus = 0;
        if (hipGetDevice(&dev) != hipSuccess || hipDeviceGetAttribute(&cus, hipDeviceAttributeMultiprocessorCount, dev) != hipSuccess) { grid = -1; return; }
        if (hipFuncSetAttribute((const void*)mk_fwd, hipFuncAttributeMaxDynamicSharedMemorySize, LDS_BYTES) != hipSuccess) { fprintf(stderr, "kernel_launch: hipFuncSetAttribute failed\n"); grid = -1; return; }
        grid = cus;
    }
    if (grid < 0) return;
    (void)hipMemsetAsync((char*)d_ws + WS_CTL, 0, CTL_BYTES, stream);
    Args a{};
    for (int i = 0; i < N_IN; ++i) a.in[i] = (const float*)d_in[i];
    a.out = (float*)d_out; a.ws = (unsigned char*)d_ws;
    for (int st = 0; st < N_STAGES; ++st) { a.st_lo = st; a.st_hi = st + 1; hipLaunchKernelGGL(mk_fwd, dim3(grid), dim3(512), LDS_BYTES, stream, a); }
}
```

```cpp
#include <hip/hip_runtime.h>
#include <hip/hip_cooperative_groups.h>
#include <cstdint>
#include <cstdio>

#define LAS __attribute__((address_space(3)))
typedef unsigned short bf16_t;
typedef short bf16x8 __attribute__((ext_vector_type(8)));
typedef float f32x4 __attribute__((ext_vector_type(4)));
typedef unsigned u32x4 __attribute__((ext_vector_type(4)));
typedef unsigned u32x2 __attribute__((ext_vector_type(2)));

constexpr int NB = 8, SEQ = 2048, NMETA = 16, LPAD = 2112, DM = 1024, MROWS = NB * SEQ;
constexpr int DFF = 2816, DIN = 5792, NGU = 2 * DFF;
constexpr int PA_N = 2816;
constexpr int OFF_CKV = 384, OFF_KR = 640, OFF_XBAR = 672, OFF_BG = 1184, OFF_CG = 1696, OFF_U = 2208, OFF_GATES = 2720;
constexpr int NSS = 20;
constexpr float ALPHA = 1.41421356237309515f;
constexpr float LN_EPS = 1e-5f, RMS_EPS = 1e-6f;
constexpr float QSCALE = 0.10206207261596577f * 1.4426950408889634f;

enum { I_X = 0, I_META, I_F1G, I_F1U, I_F1D, I_LN1G, I_LN1B, I_WIN, I_QNG, I_WUQ, I_KVNG, I_WUKV, I_WOA, I_CONVW, I_CONVB, I_WOB,
       I_SARE, I_SAIM, I_SLDT, I_SBRE, I_SBIM, I_SCRE, I_SCIM, I_SD, I_WGLU, I_BGLU, I_WOC, I_WO, I_LN2G, I_LN2B, I_F2G, I_F2U, I_F2D, I_LN3G, I_LN3B, N_IN };

constexpr size_t MiB = 1u << 20;
constexpr size_t WS_CTL = 0, CTL_BYTES = 1 * MiB;
constexpr size_t WS_TAB = 1 * MiB;
constexpr size_t TAB_COS = 0, TAB_SIN = 132096, TAB_AB = 264192, TAB_BBR = 296960, TAB_BBI = 559104;
constexpr size_t WS_META = 2 * MiB;
constexpr size_t MT_X = 0, MT_XN = 65536, MT_H = 98304, MT_PROJ = 188416, MT_Q = 278528, MT_GB = 303104, MT_YC = 319488, MT_YG = 335872, MT_SG = 352256, MT_MIX = 450560, MT_SS = 483328;
constexpr size_t WS_SS = 4 * MiB;
constexpr size_t WS_SLOT0 = 6 * MiB, WS_SLOT1 = 18 * MiB;
constexpr size_t WS_XN = 30 * MiB;
constexpr size_t WS_R1 = 62 * MiB;
constexpr size_t WS_Q = 158 * MiB;
constexpr size_t WS_KV = 182 * MiB;
constexpr size_t WS_KR = 215 * MiB;
constexpr size_t WS_GB = 217 * MiB, WS_YC = 233 * MiB, WS_YG = 249 * MiB, WS_END = 265 * MiB;

constexpr int LDS_BYTES = 147456;

#define CAS __attribute__((address_space(4)))
struct Args { const void* CAS const* kp; int opq;
    __device__ __forceinline__ const float* in(int i) const { return (const float*)kp[i + opq]; }
    __device__ __forceinline__ float* out() const { return (float*)kp[N_IN + opq]; }
    __device__ __forceinline__ unsigned char* ws() const { return (unsigned char*)kp[N_IN + 1 + opq]; } };

__device__ __forceinline__ unsigned f2bf(float f) { unsigned u = __float_as_uint(f); return (u + 0x7fffu + ((u >> 16) & 1u)) >> 16; }
__device__ __forceinline__ unsigned pk2(float lo, float hi) { return f2bf(lo) | (f2bf(hi) << 16); }
__device__ __forceinline__ float bflo(unsigned w) { return __uint_as_float(w << 16); }
__device__ __forceinline__ float bfhi(unsigned w) { return __uint_as_float(w & 0xffff0000u); }
__device__ __forceinline__ float bf2f(bf16_t h) { return __uint_as_float((unsigned)h << 16); }
__device__ __forceinline__ float sigmoidf_(float x) { return 1.0f / (1.0f + __expf(-x)); }
__device__ __forceinline__ float gelu_tanh(float x) { const float z = 0.7978845608028654f * (x + 0.044715f * x * x * x); const float e = __expf(2.0f * z); const float t = 1.0f - 2.0f / (e + 1.0f); return 0.5f * x * (1.0f + t); }
__device__ __forceinline__ float wave_sum(float v) {
#pragma unroll
    for (int o = 1; o < 64; o <<= 1) v += __shfl_xor(v, o);
    return v;
}
__device__ __forceinline__ float wave_max(float v) {
#pragma unroll
    for (int o = 1; o < 64; o <<= 1) v = fmaxf(v, __shfl_xor(v, o));
    return v;
}
__device__ __forceinline__ u32x2 pack4(f32x4 v) { u32x2 w; w.x = pk2(v[0], v[1]); w.y = pk2(v[2], v[3]); return w; }
__device__ __forceinline__ f32x4 unpack4(u32x2 w) { return (f32x4){bflo(w.x), bfhi(w.x), bflo(w.y), bfhi(w.y)}; }

struct EpiSwiglu { bf16_t* H; int ldh;
    __device__ __forceinline__ void pair(int row, int c0, f32x4 g, f32x4 u) const {
        const int hc = (c0 >> 5) * 16 + (c0 & 31); f32x4 h;
#pragma unroll
        for (int i = 0; i < 4; ++i) h[i] = g[i] * sigmoidf_(g[i]) * u[i];
        *(u32x2*)(H + (size_t)row * ldh + hc) = pack4(h); } };
struct EpiResid { const float* Xin; float* Xout; float alpha, s;
    __device__ __forceinline__ void pair(int row, int c0, f32x4 v0, f32x4 v1) const {
        const size_t o = (size_t)row * DM + c0; const f32x4 a = *(const f32x4*)(Xin + o), b = *(const f32x4*)(Xin + o + 16);
        *(f32x4*)(Xout + o) = a * alpha + v0 * s; *(f32x4*)(Xout + o + 16) = b * alpha + v1 * s; } };
struct EpiProjA { bf16_t* P; float* SS;
    __device__ __forceinline__ void pair(int row, int c0, f32x4 v0, f32x4 v1) const {
        const u32x2 w0 = pack4(v0), w1 = pack4(v1);
        *(u32x2*)(P + (size_t)row * PA_N + c0) = w0; *(u32x2*)(P + (size_t)row * PA_N + c0 + 16) = w1;
        if ((c0 >> 5) < NSS) { const f32x4 a = unpack4(w0), b = unpack4(w1);
            float ss = (a[0] * a[0] + a[1] * a[1]) + (a[2] * a[2] + a[3] * a[3]) + (b[0] * b[0] + b[1] * b[1]) + (b[2] * b[2] + b[3] * b[3]);
            ss += __shfl_xor(ss, 16); ss += __shfl_xor(ss, 32);
            if ((threadIdx.x & 63) < 16) SS[(size_t)row * NSS + (c0 >> 5)] = ss; } } };
struct EpiUq { bf16_t* Q; const float* SS; const float* rcos; const float* rsin; int posoff, posmask;
    __device__ __forceinline__ void pair(int row, int c0, f32x4 v0, f32x4 v1) const {
        const f32x4 s0 = *(const f32x4*)(SS + (size_t)row * NSS), s1 = *(const f32x4*)(SS + (size_t)row * NSS + 4), s2 = *(const f32x4*)(SS + (size_t)row * NSS + 8);
        const float ss = ((s0[0] + s0[1]) + (s0[2] + s0[3])) + ((s1[0] + s1[1]) + (s1[2] + s1[3])) + ((s2[0] + s2[1]) + (s2[2] + s2[3]));
        const float sc = rsqrtf(ss * (1.0f / 384.0f) + RMS_EPS) * QSCALE;
        v0 = v0 * sc; v1 = v1 * sc;
        if (c0 >= 512) { const int j = (c0 - 512) & 31; const int pos = posoff + (row & posmask);
            const f32x4 cs = *(const f32x4*)(rcos + pos * 16 + j), sn = *(const f32x4*)(rsin + pos * 16 + j);
            const f32x4 a = v0 * cs - v1 * sn, b = v1 * cs + v0 * sn; v0 = a; v1 = b; }
        *(u32x2*)(Q + (size_t)row * 768 + c0) = pack4(v0); *(u32x2*)(Q + (size_t)row * 768 + c0 + 16) = pack4(v1); } };
struct EpiUkv { bf16_t* KV; const float* SS; int meta;
    __device__ __forceinline__ void pair(int row, int c0, f32x4 v0, f32x4 v1) const {
        const f32x4 s0 = *(const f32x4*)(SS + (size_t)row * NSS + 12), s1 = *(const f32x4*)(SS + (size_t)row * NSS + 16);
        const float ss = ((s0[0] + s0[1]) + (s0[2] + s0[3])) + ((s1[0] + s1[1]) + (s1[2] + s1[3]));
        const float sc = rsqrtf(ss * (1.0f / 256.0f) + RMS_EPS);
        const u32x2 w0 = pack4(v0 * sc), w1 = pack4(v1 * sc);
        if (!meta) { const size_t dr = (size_t)row + 64 * (row >> 11) + 16; *(u32x2*)(KV + dr * 1024 + c0) = w0; *(u32x2*)(KV + dr * 1024 + c0 + 16) = w1; }
        else { for (int b = 0; b < NB; ++b) { const size_t dr = (size_t)b * LPAD + row; *(u32x2*)(KV + dr * 1024 + c0) = w0; *(u32x2*)(KV + dr * 1024 + c0 + 16) = w1; } } } };
struct EpiSig { bf16_t* SG;
    __device__ __forceinline__ void pair(int row, int c0, f32x4 v0, f32x4 v1) const {
        f32x4 a, b;
#pragma unroll
        for (int i = 0; i < 4; ++i) { a[i] = sigmoidf_(v0[i]); b[i] = sigmoidf_(v1[i]); }
        *(u32x2*)(SG + (size_t)row * 3072 + c0) = pack4(a); *(u32x2*)(SG + (size_t)row * 3072 + c0 + 16) = pack4(b); } };
struct EpiGlu { bf16_t* YG; const bf16_t* YC; const float* bglu;
    __device__ __forceinline__ void pair(int row, int c0, f32x4 v0, f32x4 v1) const {
        const f32x4 y0 = unpack4(*(const u32x2*)(YC + (size_t)row * 512 + c0)), y1 = unpack4(*(const u32x2*)(YC + (size_t)row * 512 + c0 + 16));
        const f32x4 b0 = *(const f32x4*)(bglu + c0), b1 = *(const f32x4*)(bglu + c0 + 16); f32x4 a, b;
#pragma unroll
        for (int i = 0; i < 4; ++i) { a[i] = y0[i] * sigmoidf_(v0[i] + b0[i]); b[i] = y1[i] * sigmoidf_(v1[i] + b1[i]); }
        *(u32x2*)(YG + (size_t)row * 512 + c0) = pack4(a); *(u32x2*)(YG + (size_t)row * 512 + c0 + 16) = pack4(b); } };
struct EpiMerge { bf16_t* MX; const bf16_t* SG; int gi; int first;
    __device__ __forceinline__ void pair(int row, int c0, f32x4 v0, f32x4 v1) const {
        const bf16_t* sg = SG + (size_t)row * 3072 + gi * 1024 + c0; bf16_t* mx = MX + (size_t)row * DM + c0;
        f32x4 a = unpack4(*(const u32x2*)sg) * v0, b = unpack4(*(const u32x2*)(sg + 16)) * v1;
        if (!first) { a = a + unpack4(*(const u32x2*)mx); b = b + unpack4(*(const u32x2*)(mx + 16)); }
        *(u32x2*)mx = pack4(a); *(u32x2*)(mx + 16) = pack4(b); } };

template <class Epi>
__device__ __forceinline__ void gemm_simple(const bf16_t* A, int lda, const bf16_t* Bt, int K, int Mr, int Nc, const Epi& E) {
    const int lane = threadIdx.x & 63, wid = threadIdx.x >> 6, fr = lane & 15, fq = lane >> 4;
    const int gw = blockIdx.x * 8 + wid, NGW = gridDim.x * 8, nct = Nc / 64, nit = (Mr / 32) * nct;
    for (int it = gw; it < nit; it += NGW) {
        const int rt = it / nct, ct = it % nct;
        f32x4 acc[2][4];
#pragma unroll
        for (int m = 0; m < 2; ++m)
#pragma unroll
            for (int n = 0; n < 4; ++n) acc[m][n] = (f32x4){0.f, 0.f, 0.f, 0.f};
        const bf16_t* ap = A + (size_t)(rt * 32 + fr) * lda + 8 * fq;
        const bf16_t* bp = Bt + (size_t)(ct * 64 + fr) * K + 8 * fq;
        for (int k0 = 0; k0 < K; k0 += 32) {
            bf16x8 a[2], b[4];
#pragma unroll
            for (int m = 0; m < 2; ++m) a[m] = *(const bf16x8*)(ap + (size_t)m * 16 * lda + k0);
#pragma unroll
            for (int n = 0; n < 4; ++n) b[n] = *(const bf16x8*)(bp + (size_t)n * 16 * K + k0);
#pragma unroll
            for (int m = 0; m < 2; ++m)
#pragma unroll
                for (int n = 0; n < 4; ++n) acc[m][n] = __builtin_amdgcn_mfma_f32_16x16x32_bf16(b[n], a[m], acc[m][n], 0, 0, 0);
        }
#pragma unroll
        for (int m = 0; m < 2; ++m)
#pragma unroll
            for (int np = 0; np < 2; ++np) E.pair(rt * 32 + m * 16 + fr, ct * 64 + np * 32 + 4 * fq, acc[m][2 * np], acc[m][2 * np + 1]);
    }
}
template <class Epi>
__device__ __forceinline__ void gemm_meta(const bf16_t* A, int lda, const bf16_t* Bt, int K, int Nc, const Epi& E, float* red) {
    const int lane = threadIdx.x & 63, wid = threadIdx.x >> 6, fr = lane & 15, fq = lane >> 4;
    for (int cg = (int)blockIdx.x; cg < Nc / 32; cg += (int)gridDim.x) {
        f32x4 a0 = (f32x4){0.f, 0.f, 0.f, 0.f}, a1 = a0;
        const bf16_t* ap = A + (size_t)fr * lda + 8 * fq;
        const bf16_t* bp = Bt + (size_t)(cg * 32 + fr) * K + 8 * fq;
        for (int ks = wid; ks < K / 32; ks += 8) {
            const bf16x8 a = *(const bf16x8*)(ap + ks * 32);
            const bf16x8 b0 = *(const bf16x8*)(bp + ks * 32), b1 = *(const bf16x8*)(bp + (size_t)16 * K + ks * 32);
            a0 = __builtin_amdgcn_mfma_f32_16x16x32_bf16(b0, a, a0, 0, 0, 0);
            a1 = __builtin_amdgcn_mfma_f32_16x16x32_bf16(b1, a, a1, 0, 0, 0);
        }
        *(f32x4*)(red + (wid * 64 + lane) * 8) = a0; *(f32x4*)(red + (wid * 64 + lane) * 8 + 4) = a1;
        __syncthreads();
        if (wid == 0) {
            f32x4 s0 = (f32x4){0.f, 0.f, 0.f, 0.f}, s1 = s0;
#pragma unroll
            for (int w = 0; w < 8; ++w) { s0 = s0 + *(const f32x4*)(red + (w * 64 + lane) * 8); s1 = s1 + *(const f32x4*)(red + (w * 64 + lane) * 8 + 4); }
            E.pair(fr, cg * 32 + 4 * fq, s0, s1);
        }
        __syncthreads();
    }
}

struct WDesc { const float* src0; const float* src1; int srcN; int K; bf16_t* dst; int rows; int kind; int coff; int nvalid; const float* scale; };
__device__ __forceinline__ void cvt_weight(const WDesc& d, float* scr_all) {
    const int lane = threadIdx.x & 63, wid = threadIdx.x >> 6;
    float* scr = scr_all + wid * (64 * 33);
    const int gw = blockIdx.x * 8 + wid, NGW = gridDim.x * 8, nblk = d.rows / 32, nit = (d.K / 64) * nblk;
    for (int it = gw; it < nit; it += NGW) {
        const int kb = it / nblk, nb = it % nblk, k0 = 64 * kb, n0 = 32 * nb;
        const int r = n0 + (lane & 31);
        const float* src = d.src0; int col = 0; bool valid = true;
        if (d.kind == 0) { valid = r < d.nvalid; col = d.coff + r; }
        else if (d.kind == 1) { const int q = r >> 5, w = r & 31; src = (w < 16) ? d.src0 : d.src1; col = 16 * q + (w & 15); }
        else { if (r < 512) col = (r >> 6) * 96 + (r & 63); else col = ((r - 512) >> 5) * 96 + 64 + ((r - 512) & 31); }
#pragma unroll 8
        for (int i = 0; i < 32; ++i) { const int kk = 2 * i + (lane >> 5);
            float v = valid ? src[(size_t)(k0 + kk) * d.srcN + col] : 0.f; if (d.scale) v *= d.scale[k0 + kk];
            scr[kk * 33 + (lane & 31)] = v; }
        const int c8 = lane & 7;
#pragma unroll
        for (int j = 0; j < 4; ++j) { const int n = (lane >> 3) + 8 * j; const float* s = scr + (8 * c8) * 33 + n;
            u32x4 o; o.x = pk2(s[0], s[33]); o.y = pk2(s[66], s[99]); o.z = pk2(s[132], s[165]); o.w = pk2(s[198], s[231]);
            *(u32x4*)(d.dst + (size_t)(n0 + n) * d.K + k0 + 8 * c8) = o; }
    }
}
__device__ __forceinline__ bf16_t* slot_ptr(const Args& a, int gp) { return (bf16_t*)(a.ws() + ((gp & 1) ? WS_SLOT1 : WS_SLOT0)); }
__device__ __forceinline__ void convert_phase(const Args& a, int l, int p, float* scr) {
    if (l > 1) return;
    bf16_t* S = slot_ptr(a, 9 * l + p);
    WDesc d; d.src1 = nullptr; d.kind = 0; d.coff = 0; d.scale = nullptr;
    if (p == 1 || p == 8) {
        d.src0 = ((p == 1) ? a.in(I_F1G) : a.in(I_F2G)) + (size_t)l * DM * DFF; d.src1 = ((p == 1) ? a.in(I_F1U) : a.in(I_F2U)) + (size_t)l * DM * DFF; d.srcN = DFF; d.K = DM; d.dst = S; d.rows = NGU; d.kind = 1; d.nvalid = NGU; cvt_weight(d, scr); }
    else if (p == 2 || p == 9) {
        d.src0 = ((p == 2) ? a.in(I_F1D) : a.in(I_F2D)) + (size_t)l * DFF * DM; d.srcN = DM; d.K = DFF; d.dst = S; d.rows = DM; d.nvalid = DM; cvt_weight(d, scr); }
    else if (p == 3) { d.src0 = a.in(I_WIN) + (size_t)l * DM * DIN; d.srcN = DIN; d.K = DM; d.dst = S; d.rows = PA_N; d.nvalid = OFF_GATES; cvt_weight(d, scr); }
    else if (p == 4) {
        d.src0 = a.in(I_WUQ) + (size_t)l * 384 * 768; d.srcN = 768; d.K = 384; d.dst = S; d.rows = 768; d.kind = 2; d.nvalid = 768; d.scale = a.in(I_QNG) + l * 384; cvt_weight(d, scr);
        d.src0 = a.in(I_WUKV) + (size_t)l * 256 * 1024; d.srcN = 1024; d.K = 256; d.dst = S + (1 * MiB) / 2; d.rows = 1024; d.kind = 0; d.nvalid = 1024; d.scale = a.in(I_KVNG) + l * 256; cvt_weight(d, scr); }
    else if (p == 5) {
        d.src0 = a.in(I_WIN) + (size_t)l * DM * DIN; d.srcN = DIN; d.K = DM; d.dst = S; d.rows = 3072; d.coff = OFF_GATES; d.nvalid = 3072; cvt_weight(d, scr);
        d.src0 = a.in(I_WGLU) + (size_t)l * 512 * 512; d.srcN = 512; d.K = 512; d.dst = S + (8 * MiB) / 2; d.rows = 512; d.coff = 0; d.nvalid = 512; cvt_weight(d, scr); }
    else if (p == 6) {
        d.srcN = DM; d.K = 512; d.rows = DM; d.nvalid = DM;
        d.src0 = a.in(I_WOA) + (size_t)l * 512 * DM; d.dst = S; cvt_weight(d, scr);
        d.src0 = a.in(I_WOB) + (size_t)l * 512 * DM; d.dst = S + (1 * MiB) / 2; cvt_weight(d, scr);
        d.src0 = a.in(I_WOC) + (size_t)l * 512 * DM; d.dst = S + (2 * MiB) / 2; cvt_weight(d, scr); }
    else if (p == 7) { d.src0 = a.in(I_WO) + (size_t)l * DM * DM; d.srcN = DM; d.K = DM; d.dst = S; d.rows = DM; d.nvalid = DM; cvt_weight(d, scr); }
}
__device__ __forceinline__ void convert_next(const Args& a, int l, int p, float* scr) { if (p == 9) convert_phase(a, l + 1, 1, scr); else convert_phase(a, l, p + 1, scr); }

__device__ __forceinline__ void ln_row(float* xrow, bf16_t* orow, const float* g, const float* b, int lane) {
    f32x4 v[4]; float s = 0.f;
#pragma unroll
    for (int j = 0; j < 4; ++j) { v[j] = *(const f32x4*)(xrow + 4 * lane + 256 * j); s += (v[j][0] + v[j][1]) + (v[j][2] + v[j][3]); }
    const float mean = wave_sum(s) * (1.f / DM); float s2 = 0.f;
#pragma unroll
    for (int j = 0; j < 4; ++j) { v[j] = v[j] - mean; s2 += (v[j][0] * v[j][0] + v[j][1] * v[j][1]) + (v[j][2] * v[j][2] + v[j][3] * v[j][3]); }
    const float rstd = rsqrtf(wave_sum(s2) * (1.f / DM) + LN_EPS);
#pragma unroll
    for (int j = 0; j < 4; ++j) { const f32x4 gg = *(const f32x4*)(g + 4 * lane + 256 * j), bb = *(const f32x4*)(b + 4 * lane + 256 * j);
        const f32x4 o = v[j] * rstd * gg + bb; *(f32x4*)(xrow + 4 * lane + 256 * j) = o; *(u32x2*)(orow + 4 * lane + 256 * j) = pack4(o); }
}
__device__ __forceinline__ void stage_ln(const Args& a, const float* g, const float* b) {
    const int lane = threadIdx.x & 63, gw = blockIdx.x * 8 + (threadIdx.x >> 6), NGW = gridDim.x * 8;
    float* Xm = (float*)(a.ws() + WS_META + MT_X); bf16_t* XNm = (bf16_t*)(a.ws() + WS_META + MT_XN); bf16_t* XN = (bf16_t*)(a.ws() + WS_XN);
    for (int r = gw; r < MROWS + NMETA; r += NGW) {
        if (r < MROWS) ln_row(a.out() + (size_t)r * DM, XN + (size_t)r * DM, g, b, lane);
        else ln_row(Xm + (size_t)(r - MROWS) * DM, XNm + (size_t)(r - MROWS) * DM, g, b, lane);
    }
}
__device__ __forceinline__ void stage_prologue(const Args& a, float* scr) {
    const int tid = threadIdx.x, gt = blockIdx.x * 512 + tid, NGT = gridDim.x * 512;
    bf16_t* XN = (bf16_t*)(a.ws() + WS_XN); float* Xm = (float*)(a.ws() + WS_META + MT_X); bf16_t* XNm = (bf16_t*)(a.ws() + WS_META + MT_XN);
    const float* x = a.in(I_X);
    for (size_t i = gt; i < (size_t)MROWS * DM / 8; i += NGT) { const f32x4 p = *(const f32x4*)(x + i * 8), q = *(const f32x4*)(x + i * 8 + 4);
        u32x4 o; o.x = pk2(p[0], p[1]); o.y = pk2(p[2], p[3]); o.z = pk2(q[0], q[1]); o.w = pk2(q[2], q[3]); *(u32x4*)(XN + i * 8) = o; }
    for (int i = gt; i < NMETA * DM; i += NGT) { const float v = a.in(I_META)[i]; Xm[i] = v; XNm[i] = (bf16_t)f2bf(v); }
    float* rc = (float*)(a.ws() + WS_TAB + TAB_COS); float* rs = (float*)(a.ws() + WS_TAB + TAB_SIN);
    for (int i = gt; i < (SEQ + NMETA) * 16; i += NGT) { const int pos = i >> 4, j = i & 15; const double inv = pow(10000.0, -(double)j / 16.0), ang = (double)pos * inv; rc[i] = (float)cos(ang); rs[i] = (float)sin(ang); }
    float* AB = (float*)(a.ws() + WS_TAB + TAB_AB); float* BBR = (float*)(a.ws() + WS_TAB + TAB_BBR); float* BBI = (float*)(a.ws() + WS_TAB + TAB_BBI);
    for (int i = gt; i < 2 * 32 * 64; i += NGT) {
        const int lg = i >> 6; const double are = a.in(I_SARE)[i], aim = a.in(I_SAIM)[i], dt = exp((double)a.in(I_SLDT)[lg]);
        const double mag = exp(dt * are), abr = mag * cos(dt * aim), abi = mag * sin(dt * aim), den = are * are + aim * aim, nr = abr - 1.0, ni = abi;
        const double cr = (nr * are + ni * aim) / den, ci = (ni * are - nr * aim) / den;
        AB[2 * i] = (float)abr; AB[2 * i + 1] = (float)abi;
        for (int h = 0; h < 16; ++h) { const double br = a.in(I_SBRE)[(size_t)i * 16 + h], bi = a.in(I_SBIM)[(size_t)i * 16 + h];
            BBR[(size_t)i * 16 + h] = (float)(cr * br - ci * bi); BBI[(size_t)i * 16 + h] = (float)(cr * bi + ci * br); } }
    convert_phase(a, 0, 1, scr);
}
__device__ __forceinline__ void stage_krope_pad(const Args& a) {
    const int gt = blockIdx.x * 512 + threadIdx.x, NGT = gridDim.x * 512;
    const bf16_t* PA = (const bf16_t*)(a.ws() + WS_R1); const bf16_t* PM = (const bf16_t*)(a.ws() + WS_META + MT_PROJ);
    bf16_t* KR = (bf16_t*)(a.ws() + WS_KR); bf16_t* KV = (bf16_t*)(a.ws() + WS_KV);
    const float* rc = (const float*)(a.ws() + WS_TAB + TAB_COS); const float* rs = (const float*)(a.ws() + WS_TAB + TAB_SIN);
    for (int i = gt; i < (MROWS + NMETA) * 16; i += NGT) { const int r = i >> 4, j = i & 15;
        if (r < MROWS) { const int pos = 16 + (r & 2047); const bf16_t* p = PA + (size_t)r * PA_N + OFF_KR; const float x1 = bf2f(p[j]), x2 = bf2f(p[j + 16]), c = rc[pos * 16 + j], s = rs[pos * 16 + j];
            bf16_t* o = KR + ((size_t)r + 64 * (r >> 11) + 16) * 32; o[j] = (bf16_t)f2bf(x1 * c - x2 * s); o[j + 16] = (bf16_t)f2bf(x2 * c + x1 * s); }
        else { const int pos = r - MROWS; const bf16_t* p = PM + (size_t)pos * PA_N + OFF_KR; const float x1 = bf2f(p[j]), x2 = bf2f(p[j + 16]), c = rc[pos * 16 + j], s = rs[pos * 16 + j];
            const bf16_t o1 = (bf16_t)f2bf(x1 * c - x2 * s), o2 = (bf16_t)f2bf(x2 * c + x1 * s);
            for (int b = 0; b < NB; ++b) { bf16_t* o = KR + ((size_t)b * LPAD + pos) * 32; o[j] = o1; o[j + 16] = o2; } } }
    for (int i = gt; i < NB * 48 * 128; i += NGT) { const int b = i / (48 * 128), rem = i % (48 * 128), rr = rem >> 7, c = rem & 127; *(u32x4*)(KV + ((size_t)b * LPAD + 2064 + rr) * 1024 + c * 8) = (u32x4){0u, 0u, 0u, 0u}; }
    for (int i = gt; i < NB * 48 * 4; i += NGT) { const int b = i / (48 * 4), rem = i % (48 * 4), rr = rem >> 2, c = rem & 3; *(u32x4*)(KR + ((size_t)b * LPAD + 2064 + rr) * 32 + c * 8) = (u32x4){0u, 0u, 0u, 0u}; }
}
__device__ __forceinline__ void stage_conv(const Args& a, int l) {
    const int gt = blockIdx.x * 512 + threadIdx.x, NGT = gridDim.x * 512;
    const bf16_t* PA = (const bf16_t*)(a.ws() + WS_R1); const bf16_t* PM = (const bf16_t*)(a.ws() + WS_META + MT_PROJ);
    bf16_t* GB = (bf16_t*)(a.ws() + WS_GB); bf16_t* GBm = (bf16_t*)(a.ws() + WS_META + MT_GB);
    const float* cw = a.in(I_CONVW) + l * 3 * 512; const float* cb = a.in(I_CONVB) + l * 512;
    for (int i = gt; i < (MROWS + NMETA) * 64; i += NGT) { const int r = i >> 6, c = (i & 63) * 8;
        const bf16_t *cur, *p1, *p2; bf16_t* dst;
        if (r < MROWS) { const int t = r & 2047; cur = PA + (size_t)r * PA_N; p1 = (t >= 1) ? cur - PA_N : PM + 15 * PA_N; p2 = (t >= 2) ? cur - 2 * PA_N : (t == 1 ? PM + 15 * PA_N : PM + 14 * PA_N); dst = GB + (size_t)r * 512 + c; }
        else { const int t = r - MROWS; cur = PM + (size_t)t * PA_N; p1 = (t >= 1) ? cur - PA_N : nullptr; p2 = (t >= 2) ? cur - 2 * PA_N : nullptr; dst = GBm + (size_t)t * 512 + c; }
        const u32x4 xb0 = *(const u32x4*)(cur + OFF_XBAR + c), cg0 = *(const u32x4*)(cur + OFF_CG + c), bg = *(const u32x4*)(cur + OFF_BG + c);
        u32x4 xb1 = (u32x4){0u, 0u, 0u, 0u}, cg1 = xb1, xb2 = xb1, cg2 = xb1;
        if (p1) { xb1 = *(const u32x4*)(p1 + OFF_XBAR + c); cg1 = *(const u32x4*)(p1 + OFF_CG + c); }
        if (p2) { xb2 = *(const u32x4*)(p2 + OFF_XBAR + c); cg2 = *(const u32x4*)(p2 + OFF_CG + c); }
        u32x4 o;
#pragma unroll
        for (int q = 0; q < 4; ++q) {
            const int ce = c + 2 * q;
            const float u0l = bflo(cg0[q]) * bflo(xb0[q]), u0h = bfhi(cg0[q]) * bfhi(xb0[q]);
            const float u1l = bflo(cg1[q]) * bflo(xb1[q]), u1h = bfhi(cg1[q]) * bfhi(xb1[q]);
            const float u2l = bflo(cg2[q]) * bflo(xb2[q]), u2h = bfhi(cg2[q]) * bfhi(xb2[q]);
            const float yl = cb[ce] + cw[ce] * u2l + cw[512 + ce] * u1l + cw[1024 + ce] * u0l;
            const float yh = cb[ce + 1] + cw[ce + 1] * u2h + cw[512 + ce + 1] * u1h + cw[1024 + ce + 1] * u0h;
            o[q] = pk2(bflo(bg[q]) * yl, bfhi(bg[q]) * yh); }
        *(u32x4*)dst = o; }
}
__device__ __forceinline__ void stage_s5(const Args& a, int l, unsigned char* lds) {
    float* E = (float*)lds; float* Cp = (float*)(lds + 4096); float* Xs = (float*)(lds + 12288);
    const int tid = threadIdx.x, lane = tid & 63, wid = tid >> 6;
    const bf16_t* PA = (const bf16_t*)(a.ws() + WS_R1); const bf16_t* PM = (const bf16_t*)(a.ws() + WS_META + MT_PROJ);
    bf16_t* YC = (bf16_t*)(a.ws() + WS_YC); bf16_t* YCm = (bf16_t*)(a.ws() + WS_META + MT_YC);
    const float* AB = (const float*)(a.ws() + WS_TAB + TAB_AB); const float* BBR = (const float*)(a.ws() + WS_TAB + TAB_BBR); const float* BBI = (const float*)(a.ws() + WS_TAB + TAB_BBI);
    float* xs = Xs + wid * (16 * 129);
    for (int it = (int)blockIdx.x; it < NB * 32; it += (int)gridDim.x) {
        const int b = it >> 5, g = it & 31, pi_ = (l * 32 + g) * 64 + lane;
        const float abr = AB[2 * pi_], abi = AB[2 * pi_ + 1];
        float br[16], bi[16];
#pragma unroll
        for (int h = 0; h < 16; ++h) { br[h] = BBR[(size_t)pi_ * 16 + h]; bi[h] = BBI[(size_t)pi_ * 16 + h]; }
        __syncthreads();
        for (int idx = tid; idx < 2048; idx += 512) { const int k = idx >> 4, h = idx & 15;
            Cp[idx] = (k < 64) ? a.in(I_SCRE)[((size_t)(l * 32 + g) * 16 + h) * 64 + k] : -a.in(I_SCIM)[((size_t)(l * 32 + g) * 16 + h) * 64 + (k - 64)]; }
        const int uoff = OFF_U + 16 * g;
        const bf16_t* ubase = PA + ((size_t)b * SEQ + 256 * wid) * PA_N + uoff;
        float xr = 0.f, xi = 0.f;
#define S5_STEP(UP) do { const u32x4 w0_ = *(const u32x4*)(UP), w1_ = *(const u32x4*)((UP) + 8); float bur = 0.f, bui = 0.f; \
            _Pragma("unroll") for (int q = 0; q < 4; ++q) { const float ul = bflo(w0_[q]), uh = bfhi(w0_[q]), vl = bflo(w1_[q]), vh = bfhi(w1_[q]); \
                bur += br[2 * q] * ul + br[2 * q + 1] * uh + br[8 + 2 * q] * vl + br[8 + 2 * q + 1] * vh; bui += bi[2 * q] * ul + bi[2 * q + 1] * uh + bi[8 + 2 * q] * vl + bi[8 + 2 * q + 1] * vh; } \
            const float nxr = abr * xr - abi * xi + bur, nxi = abr * xi + abi * xr + bui; xr = nxr; xi = nxi; } while (0)
        if (wid == 0) for (int r = 0; r < NMETA; ++r) S5_STEP(PM + (size_t)r * PA_N + uoff);
        for (int t = 0; t < 256; ++t) S5_STEP(ubase + (size_t)t * PA_N);
        E[(wid * 64 + lane) * 2] = xr; E[(wid * 64 + lane) * 2 + 1] = xi;
        __syncthreads();
        float pr = abr, pim = abi;
#pragma unroll
        for (int s = 0; s < 8; ++s) { const float nr = pr * pr - pim * pim, ni = 2.f * pr * pim; pr = nr; pim = ni; }
        xr = 0.f; xi = 0.f;
        for (int v = 0; v < wid; ++v) { const float er = E[(v * 64 + lane) * 2], ei = E[(v * 64 + lane) * 2 + 1]; const float nr = pr * xr - pim * xi + er, ni = pr * xi + pim * xr + ei; xr = nr; xi = ni; }
        const int tl = lane >> 2, hq = lane & 3;
        const f32x4 dv = *(const f32x4*)(a.in(I_SD) + (size_t)(l * 32 + g) * 16 + 4 * hq);
        for (int sc = (wid == 0 ? -1 : 0); sc < 16; ++sc) {
            const bf16_t* ub = (sc < 0) ? PM + uoff : ubase + (size_t)(16 * sc) * PA_N;
            for (int t = 0; t < 16; ++t) { S5_STEP(ub + (size_t)t * PA_N); xs[t * 129 + lane] = xr; xs[t * 129 + 64 + lane] = xi; }
            f32x4 acc = (f32x4){0.f, 0.f, 0.f, 0.f};
#pragma unroll 8
            for (int k = 0; k < 128; ++k) { const float xv = xs[tl * 129 + k]; const f32x4 cv = *(const f32x4*)(Cp + k * 16 + 4 * hq); acc = acc + cv * xv; }
            const f32x4 uv = unpack4(*(const u32x2*)(ub + (size_t)tl * PA_N + 4 * hq));
            f32x4 y = acc + dv * uv;
#pragma unroll
            for (int i = 0; i < 4; ++i) y[i] = gelu_tanh(y[i]);
            if (sc >= 0) *(u32x2*)(YC + ((size_t)b * SEQ + 256 * wid + 16 * sc + tl) * 512 + 16 * g + 4 * hq) = pack4(y);
            else if (b == 0) *(u32x2*)(YCm + (size_t)tl * 512 + 16 * g + 4 * hq) = pack4(y);
        }
#undef S5_STEP
    }
}
__device__ __forceinline__ void stage_attn_simple(const Args& a) {
    const int lane = threadIdx.x & 63, gw = blockIdx.x * 8 + (threadIdx.x >> 6), NGW = gridDim.x * 8;
    const bf16_t* KV = (const bf16_t*)(a.ws() + WS_KV); const bf16_t* KR = (const bf16_t*)(a.ws() + WS_KR);
    bf16_t* Q = (bf16_t*)(a.ws() + WS_Q); bf16_t* Qm = (bf16_t*)(a.ws() + WS_META + MT_Q);
    constexpr int NMAIN = MROWS * 8;
    for (int it = gw; it < NMAIN + NMETA * 8; it += NGW) {
        int h, pos; bf16_t* qp; size_t kvb;
        if (it < NMAIN) { h = it & 7; const int r = it >> 3; pos = 16 + (r & 2047); qp = Q + (size_t)r * 768; kvb = (size_t)(r >> 11) * LPAD; }
        else { const int j = it - NMAIN; h = j & 7; const int r = j >> 3; pos = r; qp = Qm + (size_t)r * 768; kvb = 0; }
        const float qa = bf2f(qp[h * 64 + lane]); const float qb = bf2f(qp[512 + h * 32 + (lane & 31)]);
        float m = -INFINITY, lsum = 0.f, o = 0.f;
        for (int kc = 0; kc * 64 <= pos; ++kc) {
            const int p = kc * 64 + lane; const bool valid = p <= pos;
            const bf16_t* kp = KV + (kvb + p) * 1024 + h * 128; const bf16_t* rp = KR + (kvb + p) * 32;
            float s = 0.f;
#pragma unroll
            for (int c = 0; c < 8; ++c) { const u32x4 w = *(const u32x4*)(kp + c * 8);
#pragma unroll
                for (int q = 0; q < 4; ++q) { s += __shfl(qa, c * 8 + 2 * q) * bflo(w[q]); s += __shfl(qa, c * 8 + 2 * q + 1) * bfhi(w[q]); } }
#pragma unroll
            for (int c = 0; c < 4; ++c) { const u32x4 w = *(const u32x4*)(rp + c * 8);
#pragma unroll
                for (int q = 0; q < 4; ++q) { s += __shfl(qb, c * 8 + 2 * q) * bflo(w[q]); s += __shfl(qb, c * 8 + 2 * q + 1) * bfhi(w[q]); } }
            s = valid ? s : -INFINITY;
            const float mn = fmaxf(m, wave_max(s)); const float alpha = exp2f(m - mn); const float pj = valid ? exp2f(s - mn) : 0.f;
            lsum = lsum * alpha + wave_sum(pj); o *= alpha; m = mn;
            const int nj = min(64, pos + 1 - kc * 64);
            const bf16_t* vp = KV + (kvb + kc * 64) * 1024 + h * 128 + 64 + lane;
            for (int j = 0; j < nj; ++j) o += __shfl(pj, j) * bf2f(vp[(size_t)j * 1024]);
        }
        qp[h * 64 + lane] = (bf16_t)f2bf(o / lsum);
    }
}

constexpr int N_STAGES = 25;
template <int st> __device__ __forceinline__ void run_stage(unsigned char* lds) {
    int opq; asm volatile("s_mov_b32 %0, 0" : "=s"(opq));
    Args a; a.kp = (const void* CAS const*)__builtin_amdgcn_kernarg_segment_ptr(); a.opq = opq;
    float* scr = (float*)lds;
    unsigned char* ws = a.ws();
    bf16_t* XN = (bf16_t*)(ws + WS_XN); bf16_t* R1 = (bf16_t*)(ws + WS_R1); bf16_t* Q = (bf16_t*)(ws + WS_Q); bf16_t* KV = (bf16_t*)(ws + WS_KV);
    bf16_t* GB = (bf16_t*)(ws + WS_GB); bf16_t* YC = (bf16_t*)(ws + WS_YC); bf16_t* YG = (bf16_t*)(ws + WS_YG); float* SS = (float*)(ws + WS_SS);
    unsigned char* mt = ws + WS_META;
    float* Xm = (float*)(mt + MT_X); bf16_t* XNm = (bf16_t*)(mt + MT_XN); bf16_t* Hm = (bf16_t*)(mt + MT_H); bf16_t* PM = (bf16_t*)(mt + MT_PROJ); bf16_t* Qm = (bf16_t*)(mt + MT_Q);
    bf16_t* GBm = (bf16_t*)(mt + MT_GB); bf16_t* YCm = (bf16_t*)(mt + MT_YC); bf16_t* YGm = (bf16_t*)(mt + MT_YG); bf16_t* SGm = (bf16_t*)(mt + MT_SG); bf16_t* MXm = (bf16_t*)(mt + MT_MIX); float* SSm = (float*)(mt + MT_SS);
    const float* rc = (const float*)(ws + WS_TAB + TAB_COS); const float* rs = (const float*)(ws + WS_TAB + TAB_SIN);
    if (st == 0) { stage_prologue(a, scr); return; }
    constexpr int l = (st - 1) / 12, s = (st - 1) % 12;
    const float* xin = (l == 0) ? a.in(I_X) : a.out();
    if (s == 0 || s == 9) {
        const int p = (s == 0) ? 1 : 8; const bf16_t* W = slot_ptr(a, 9 * l + p);
        gemm_simple(XN, DM, W, DM, MROWS, NGU, EpiSwiglu{R1, DFF});
        gemm_meta(XNm, DM, W, DM, NGU, EpiSwiglu{Hm, DFF}, scr);
        convert_next(a, l, p, scr);
    } else if (s == 1 || s == 10) {
        const int p = (s == 1) ? 2 : 9; const bf16_t* W = slot_ptr(a, 9 * l + p);
        const float* xi_ = (s == 1) ? xin : a.out();
        gemm_simple(R1, DFF, W, DFF, MROWS, DM, EpiResid{xi_, a.out(), ALPHA, 0.5f});
        gemm_meta(Hm, DFF, W, DFF, DM, EpiResid{Xm, Xm, ALPHA, 0.5f}, scr);
        convert_next(a, l, p, scr);
    } else if (s == 2) { stage_ln(a, a.in(I_LN1G) + l * DM, a.in(I_LN1B) + l * DM);
    } else if (s == 8) { stage_ln(a, a.in(I_LN2G) + l * DM, a.in(I_LN2B) + l * DM);
    } else if (s == 11) { stage_ln(a, a.in(I_LN3G) + l * DM, a.in(I_LN3B) + l * DM);
    } else if (s == 3) {
        const bf16_t* W = slot_ptr(a, 9 * l + 3);
        gemm_simple(XN, DM, W, DM, MROWS, PA_N, EpiProjA{R1, SS});
        gemm_meta(XNm, DM, W, DM, PA_N, EpiProjA{PM, SSm}, scr);
        convert_next(a, l, 3, scr);
    } else if (s == 4) {
        const bf16_t* W = slot_ptr(a, 9 * l + 4);
        gemm_simple(R1, PA_N, W, 384, MROWS, 768, EpiUq{Q, SS, rc, rs, 16, 2047});
        gemm_meta(PM, PA_N, W, 384, 768, EpiUq{Qm, SSm, rc, rs, 0, 15}, scr);
        gemm_simple(R1 + OFF_CKV, PA_N, W + (1 * MiB) / 2, 256, MROWS, 1024, EpiUkv{KV, SS, 0});
        gemm_meta(PM + OFF_CKV, PA_N, W + (1 * MiB) / 2, 256, 1024, EpiUkv{KV, SSm, 1}, scr);
        stage_krope_pad(a);
        stage_conv(a, l);
        __syncthreads();
        stage_s5(a, l, lds);
        __syncthreads();
        convert_next(a, l, 4, scr);
    } else if (s == 5) {
        const bf16_t* W = slot_ptr(a, 9 * l + 5);
        stage_attn_simple(a);
        gemm_simple(YC, 512, W + (8 * MiB) / 2, 512, MROWS, 512, EpiGlu{YG, YC, a.in(I_BGLU) + l * 512});
        gemm_meta(YCm, 512, W + (8 * MiB) / 2, 512, 512, EpiGlu{YGm, YCm, a.in(I_BGLU) + l * 512}, scr);
        gemm_simple(XN, DM, W, DM, MROWS, 3072, EpiSig{R1});
        gemm_meta(XNm, DM, W, DM, 3072, EpiSig{SGm}, scr);
        convert_next(a, l, 5, scr);
    } else if (s == 6) {
        const bf16_t* W = slot_ptr(a, 9 * l + 6);
        gemm_simple(Q, 768, W, 512, MROWS, DM, EpiMerge{KV, R1, 0, 1});
        gemm_simple(GB, 512, W + (1 * MiB) / 2, 512, MROWS, DM, EpiMerge{KV, R1, 1, 0});
        gemm_simple(YG, 512, W + (2 * MiB) / 2, 512, MROWS, DM, EpiMerge{KV, R1, 2, 0});
        gemm_meta(Qm, 768, W, 512, DM, EpiMerge{MXm, SGm, 0, 1}, scr);
        gemm_meta(GBm, 512, W + (1 * MiB) / 2, 512, DM, EpiMerge{MXm, SGm, 1, 0}, scr);
        gemm_meta(YGm, 512, W + (2 * MiB) / 2, 512, DM, EpiMerge{MXm, SGm, 2, 0}, scr);
        convert_next(a, l, 6, scr);
    } else if (s == 7) {
        const bf16_t* W = slot_ptr(a, 9 * l + 7);
        gemm_simple(KV, DM, W, DM, MROWS, DM, EpiResid{a.out(), a.out(), ALPHA, 1.0f});
        gemm_meta(MXm, DM, W, DM, DM, EpiResid{Xm, Xm, ALPHA, 1.0f}, scr);
        convert_next(a, l, 7, scr);
    }
}

#define XB_TMO      128
#define XB_XCNT(j)  (256  + 64 * (j))
#define XB_XSUB(j)  (1280 + 64 * (j))
#define XB_XGEN(j)  (2304 + 64 * (j))
#define XB_TOP      3328
#define XB_TOPGEN   3392
#define XCD_BAR_WORDS 3456
#define XB_SPIN_CAP (1u << 18)
__device__ __forceinline__ unsigned xb_ld(unsigned* p)              { return __hip_atomic_load(p, __ATOMIC_RELAXED, __HIP_MEMORY_SCOPE_AGENT); }
__device__ __forceinline__ unsigned xb_add(unsigned* p, unsigned v) { return __hip_atomic_fetch_add(p, v, __ATOMIC_RELAXED, __HIP_MEMORY_SCOPE_AGENT); }
__device__ __forceinline__ unsigned xb_xcc_id() { return (unsigned)__builtin_amdgcn_s_getreg((3 << 11) | 20) & 0xFu; }
#define XB_SPIN(cond, bar) do { unsigned _sp = 0; while (cond) { __builtin_amdgcn_s_sleep(1); \
    if ((++_sp & 255u) == 0u) { if (xb_ld(&(bar)[XB_TMO])) break; if (_sp > XB_SPIN_CAP) { atomicAdd(&(bar)[XB_TMO], 1u); break; } } } } while (0)
struct XcdBarrier { unsigned* bar; unsigned x; volatile LAS unsigned* st; };
__device__ __forceinline__ XcdBarrier xcd_barrier_post(unsigned* bar, volatile LAS unsigned* st) {
    XcdBarrier b; b.bar = bar; b.x = xb_xcc_id(); b.st = st;
    if (threadIdx.x == 0) (void)xb_add(&bar[XB_XCNT(b.x)], 1u);
    return b;
}
__device__ __forceinline__ void xcd_barrier_complete(unsigned* bar, unsigned x, unsigned& nloc, unsigned& nx) {
    const unsigned G = gridDim.x * gridDim.y * gridDim.z;
    unsigned sum, cnt, mine, sp = 0u;
    for (;;) {
        sum = 0u; cnt = 0u; mine = 0u;
#pragma unroll
        for (unsigned j = 0; j < 16; ++j) { const unsigned c = xb_ld(&bar[XB_XCNT(j)]); sum += c; cnt += (c > 0u) ? 1u : 0u; mine = (j == x) ? c : mine; }
        if (sum == G) break;
        __builtin_amdgcn_s_sleep(1);
        if ((++sp & 255u) == 0u) { if (xb_ld(&bar[XB_TMO])) break; if (sp > XB_SPIN_CAP) { atomicAdd(&bar[XB_TMO], 1u); break; } }
    }
    nloc = mine > 0u ? mine : 1u; nx = cnt > 0u ? cnt : 1u;
}
__device__ __forceinline__ void xcd_barrier(const XcdBarrier& b) {
    asm volatile("s_waitcnt vmcnt(0)" ::: "memory");
    __syncthreads();
    if (threadIdx.x == 0) {
        unsigned* bar = b.bar;
        __builtin_amdgcn_s_waitcnt(0);
        unsigned nloc = b.st[0], nx = b.st[1];
        if (nloc == 0u) { xcd_barrier_complete(bar, b.x, nloc, nx); b.st[0] = nloc; b.st[1] = nx; }
        const unsigned old = xb_add(&bar[XB_XSUB(b.x)], 1u);
        const unsigned gen = old / nloc;
        if (old + 1u == (gen + 1u) * nloc) {
            __builtin_amdgcn_fence(__ATOMIC_RELEASE, "agent");
            asm volatile("s_waitcnt vmcnt(0)" ::: "memory");
            const unsigned og = xb_add(&bar[XB_TOP], 1u);
            const unsigned tg = og / nx;
            if (og + 1u == (tg + 1u) * nx) xb_add(&bar[XB_TOPGEN], 1u);
            else XB_SPIN(xb_ld(&bar[XB_TOPGEN]) == tg, bar);
            __builtin_amdgcn_fence(__ATOMIC_ACQUIRE, "agent");
            xb_add(&bar[XB_XGEN(b.x)], 1u);
            asm volatile("s_waitcnt vmcnt(0)" ::: "memory");
        } else {
            XB_SPIN(xb_ld(&bar[XB_XGEN(b.x)]) == gen, bar);
            __builtin_amdgcn_fence(__ATOMIC_ACQUIRE, "agent");
            asm volatile("s_waitcnt vmcnt(0)" ::: "memory");
        }
    }
    __syncthreads();
}

template <int ST> __device__ __forceinline__ void run_from(unsigned char* lds, const XcdBarrier& bar, int lo, int hi) {
    if constexpr (ST < N_STAGES) {
        if (lo <= ST && ST < hi) {
            run_stage<ST>(lds);
            if (ST + 1 < hi) { if (ST == 0) cooperative_groups::this_grid().sync(); else xcd_barrier(bar); }
        }
        run_from<ST + 1>(lds, bar, lo, hi);
    }
}
constexpr int LDSCTL_OFF = 131072, MISC_OFF = LDSCTL_OFF + 320;
constexpr int CW_BAR = 4096;
struct KArgs { const void* p[N_IN + 2]; int st_lo, st_hi; };

__global__ void __launch_bounds__(512, 2) mk_fwd(KArgs ka) {
    extern __shared__ __attribute__((aligned(16))) unsigned char lds[];
    namespace cg = cooperative_groups;
    const bool multi = (ka.st_hi - ka.st_lo) > 1;
    XcdBarrier bar; bar.bar = nullptr; bar.x = 0; bar.st = nullptr;
    if (multi) {
        for (int u = threadIdx.x; u < (LDS_BYTES - LDSCTL_OFF) / 4; u += 512) ((LAS unsigned*)((LAS unsigned char*)lds + LDSCTL_OFF))[u] = 0u;
        __syncthreads();
        unsigned* ctl = (unsigned*)((unsigned char*)ka.p[N_IN + 1] + WS_CTL);
        bar = xcd_barrier_post(ctl + CW_BAR, (volatile LAS unsigned*)((LAS unsigned char*)lds + MISC_OFF) + 8);
    }
    run_from<0>(lds, bar, ka.st_lo, ka.st_hi);
}

extern "C" void kernel_launch(void* const* d_in, const int* in_sizes, int n_in, void* d_out, int out_size, void* d_ws, size_t ws_size, hipStream_t stream) {
    static int grid = 0;
    if (grid == 0) {
        if (n_in != N_IN || out_size != MROWS * DM || ws_size < WS_END) { fprintf(stderr, "kernel_launch: unexpected shapes (n_in %d, out %d, ws %zu)\n", n_in, out_size, ws_size); grid = -1; return; }
        int dev = 0, cus = 0, per_cu = 0;
        if (hipGetDevice(&dev) != hipSuccess || hipDeviceGetAttribute(&cus, hipDeviceAttributeMultiprocessorCount, dev) != hipSuccess) { grid = -1; return; }
        if (hipFuncSetAttribute((const void*)mk_fwd, hipFuncAttributeMaxDynamicSharedMemorySize, LDS_BYTES) != hipSuccess) { fprintf(stderr, "kernel_launch: hipFuncSetAttribute failed\n"); grid = -1; return; }
        if (hipOccupancyMaxActiveBlocksPerMultiprocessor(&per_cu, (const void*)mk_fwd, 512, LDS_BYTES) != hipSuccess || per_cu < 1) { fprintf(stderr, "kernel_launch: occupancy query says %d blocks per CU\n", per_cu); (void)hipGetLastError(); grid = -1; return; }
        grid = cus;
    }
    if (grid < 0) return;
    (void)hipMemsetAsync((char*)d_ws + WS_CTL, 0, CTL_BYTES, stream);
    KArgs a{};
    for (int i = 0; i < N_IN; ++i) a.p[i] = d_in[i];
    a.p[N_IN] = d_out; a.p[N_IN + 1] = d_ws; a.st_lo = 0; a.st_hi = N_STAGES;
    void* args[] = {&a};
    hipError_t e = hipLaunchCooperativeKernel((const void*)mk_fwd, dim3(grid), dim3(512), args, LDS_BYTES, stream);
    if (e != hipSuccess) fprintf(stderr, "kernel_launch: cooperative launch failed: %s (grid %d)\n", hipGetErrorString(e), grid);
}
```

```cpp
#include <hip/hip_runtime.h>
#include <hip/hip_cooperative_groups.h>
#include <cstdint>
#include <cstdio>

#define LAS __attribute__((address_space(3)))
typedef unsigned short bf16_t;
typedef short bf16x8 __attribute__((ext_vector_type(8)));
typedef float f32x4 __attribute__((ext_vector_type(4)));
typedef unsigned u32x4 __attribute__((ext_vector_type(4)));
typedef unsigned u32x2 __attribute__((ext_vector_type(2)));

constexpr int NB = 8, SEQ = 2048, NMETA = 16, LPAD = 2112, DM = 1024, MROWS = NB * SEQ;
constexpr int DFF = 2816, DIN = 5792, NGU = 2 * DFF;
constexpr int PA_N = 2816;
constexpr int OFF_CKV = 384, OFF_KR = 640, OFF_XBAR = 672, OFF_BG = 1184, OFF_CG = 1696, OFF_U = 2208, OFF_GATES = 2720;
constexpr int NSS = 20;
constexpr float ALPHA = 1.41421356237309515f;
constexpr float LN_EPS = 1e-5f, RMS_EPS = 1e-6f;
constexpr float QSCALE = 0.10206207261596577f * 1.4426950408889634f;

enum { I_X = 0, I_META, I_F1G, I_F1U, I_F1D, I_LN1G, I_LN1B, I_WIN, I_QNG, I_WUQ, I_KVNG, I_WUKV, I_WOA, I_CONVW, I_CONVB, I_WOB,
       I_SARE, I_SAIM, I_SLDT, I_SBRE, I_SBIM, I_SCRE, I_SCIM, I_SD, I_WGLU, I_BGLU, I_WOC, I_WO, I_LN2G, I_LN2B, I_F2G, I_F2U, I_F2D, I_LN3G, I_LN3B, N_IN };

constexpr size_t MiB = 1u << 20;
constexpr size_t WS_CTL = 0, CTL_BYTES = 1 * MiB;
constexpr size_t WS_TAB = 1 * MiB;
constexpr size_t TAB_COS = 0, TAB_SIN = 132096, TAB_AB = 264192, TAB_BBR = 296960, TAB_BBI = 559104;
constexpr size_t WS_META = 2 * MiB;
constexpr size_t MT_X = 0, MT_XN = 65536, MT_H = 98304, MT_PROJ = 188416, MT_Q = 278528, MT_GB = 303104, MT_YC = 319488, MT_YG = 335872, MT_SG = 352256, MT_MIX = 450560, MT_SS = 483328;
constexpr size_t WS_SS = 4 * MiB;
constexpr size_t WS_SLOT0 = 6 * MiB, WS_SLOT1 = 18 * MiB;
constexpr size_t WS_XN = 30 * MiB;
constexpr size_t WS_R1 = 62 * MiB;
constexpr size_t WS_Q = 158 * MiB;
constexpr size_t WS_KV = 182 * MiB;
constexpr size_t WS_KR = 215 * MiB;
constexpr size_t WS_GB = 217 * MiB, WS_YC = 233 * MiB, WS_YG = 249 * MiB, WS_END = 265 * MiB;

constexpr int LDS_BYTES = 147456;

#define CAS __attribute__((address_space(4)))
struct Args { const void* CAS const* kp; int opq;
    __device__ __forceinline__ const float* in(int i) const { return (const float*)kp[i + opq]; }
    __device__ __forceinline__ float* out() const { return (float*)kp[N_IN + opq]; }
    __device__ __forceinline__ unsigned char* ws() const { return (unsigned char*)kp[N_IN + 1 + opq]; } };

__device__ __forceinline__ unsigned f2bf(float f) { unsigned u = __float_as_uint(f); return (u + 0x7fffu + ((u >> 16) & 1u)) >> 16; }
__device__ __forceinline__ unsigned pk2(float lo, float hi) { return f2bf(lo) | (f2bf(hi) << 16); }
__device__ __forceinline__ float bflo(unsigned w) { return __uint_as_float(w << 16); }
__device__ __forceinline__ float bfhi(unsigned w) { return __uint_as_float(w & 0xffff0000u); }
__device__ __forceinline__ float bf2f(bf16_t h) { return __uint_as_float((unsigned)h << 16); }
__device__ __forceinline__ float sigmoidf_(float x) { return 1.0f / (1.0f + __expf(-x)); }
__device__ __forceinline__ float gelu_tanh(float x) { const float z = 0.7978845608028654f * (x + 0.044715f * x * x * x); const float e = __expf(2.0f * z); const float t = 1.0f - 2.0f / (e + 1.0f); return 0.5f * x * (1.0f + t); }
__device__ __forceinline__ float wave_sum(float v) {
#pragma unroll
    for (int o = 1; o < 64; o <<= 1) v += __shfl_xor(v, o);
    return v;
}
__device__ __forceinline__ float wave_max(float v) {
#pragma unroll
    for (int o = 1; o < 64; o <<= 1) v = fmaxf(v, __shfl_xor(v, o));
    return v;
}
__device__ __forceinline__ u32x2 pack4(f32x4 v) { u32x2 w; w.x = pk2(v[0], v[1]); w.y = pk2(v[2], v[3]); return w; }
__device__ __forceinline__ f32x4 unpack4(u32x2 w) { return (f32x4){bflo(w.x), bfhi(w.x), bflo(w.y), bfhi(w.y)}; }

struct EpiSwiglu { bf16_t* H; int ldh;
    __device__ __forceinline__ void pair(int row, int c0, f32x4 g, f32x4 u) const {
        const int hc = (c0 >> 5) * 16 + (c0 & 31); f32x4 h;
#pragma unroll
        for (int i = 0; i < 4; ++i) h[i] = g[i] * sigmoidf_(g[i]) * u[i];
        *(u32x2*)(H + (size_t)row * ldh + hc) = pack4(h); } };
struct EpiResid { const float* Xin; float* Xout; float alpha, s;
    __device__ __forceinline__ void pair(int row, int c0, f32x4 v0, f32x4 v1) const {
        const size_t o = (size_t)row * DM + c0; const f32x4 a = *(const f32x4*)(Xin + o), b = *(const f32x4*)(Xin + o + 16);
        *(f32x4*)(Xout + o) = a * alpha + v0 * s; *(f32x4*)(Xout + o + 16) = b * alpha + v1 * s; } };
struct EpiProjA { bf16_t* P; float* SS;
    __device__ __forceinline__ void pair(int row, int c0, f32x4 v0, f32x4 v1) const {
        const u32x2 w0 = pack4(v0), w1 = pack4(v1);
        *(u32x2*)(P + (size_t)row * PA_N + c0) = w0; *(u32x2*)(P + (size_t)row * PA_N + c0 + 16) = w1;
        if ((c0 >> 5) < NSS) { const f32x4 a = unpack4(w0), b = unpack4(w1);
            float ss = (a[0] * a[0] + a[1] * a[1]) + (a[2] * a[2] + a[3] * a[3]) + (b[0] * b[0] + b[1] * b[1]) + (b[2] * b[2] + b[3] * b[3]);
            ss += __shfl_xor(ss, 16); ss += __shfl_xor(ss, 32);
            if ((threadIdx.x & 63) < 16) SS[(size_t)row * NSS + (c0 >> 5)] = ss; } } };
struct EpiUq { bf16_t* Q; const float* SS; const float* rcos; const float* rsin; int posoff, posmask;
    __device__ __forceinline__ void pair(int row, int c0, f32x4 v0, f32x4 v1) const {
        const f32x4 s0 = *(const f32x4*)(SS + (size_t)row * NSS), s1 = *(const f32x4*)(SS + (size_t)row * NSS + 4), s2 = *(const f32x4*)(SS + (size_t)row * NSS + 8);
        const float ss = ((s0[0] + s0[1]) + (s0[2] + s0[3])) + ((s1[0] + s1[1]) + (s1[2] + s1[3])) + ((s2[0] + s2[1]) + (s2[2] + s2[3]));
        const float sc = rsqrtf(ss * (1.0f / 384.0f) + RMS_EPS) * QSCALE;
        v0 = v0 * sc; v1 = v1 * sc;
        if (c0 >= 512) { const int j = (c0 - 512) & 31; const int pos = posoff + (row & posmask);
            const f32x4 cs = *(const f32x4*)(rcos + pos * 16 + j), sn = *(const f32x4*)(rsin + pos * 16 + j);
            const f32x4 a = v0 * cs - v1 * sn, b = v1 * cs + v0 * sn; v0 = a; v1 = b; }
        *(u32x2*)(Q + (size_t)row * 768 + c0) = pack4(v0); *(u32x2*)(Q + (size_t)row * 768 + c0 + 16) = pack4(v1); } };
struct EpiUkv { bf16_t* KV; const float* SS; int meta;
    __device__ __forceinline__ void pair(int row, int c0, f32x4 v0, f32x4 v1) const {
        const f32x4 s0 = *(const f32x4*)(SS + (size_t)row * NSS + 12), s1 = *(const f32x4*)(SS + (size_t)row * NSS + 16);
        const float ss = ((s0[0] + s0[1]) + (s0[2] + s0[3])) + ((s1[0] + s1[1]) + (s1[2] + s1[3]));
        const float sc = rsqrtf(ss * (1.0f / 256.0f) + RMS_EPS);
        const u32x2 w0 = pack4(v0 * sc), w1 = pack4(v1 * sc);
        if (!meta) { const size_t dr = (size_t)row + 64 * (row >> 11) + 16; *(u32x2*)(KV + dr * 1024 + c0) = w0; *(u32x2*)(KV + dr * 1024 + c0 + 16) = w1; }
        else { for (int b = 0; b < NB; ++b) { const size_t dr = (size_t)b * LPAD + row; *(u32x2*)(KV + dr * 1024 + c0) = w0; *(u32x2*)(KV + dr * 1024 + c0 + 16) = w1; } } } };
struct EpiSig { bf16_t* SG;
    __device__ __forceinline__ void pair(int row, int c0, f32x4 v0, f32x4 v1) const {
        f32x4 a, b;
#pragma unroll
        for (int i = 0; i < 4; ++i) { a[i] = sigmoidf_(v0[i]); b[i] = sigmoidf_(v1[i]); }
        *(u32x2*)(SG + (size_t)row * 3072 + c0) = pack4(a); *(u32x2*)(SG + (size_t)row * 3072 + c0 + 16) = pack4(b); } };
struct EpiGlu { bf16_t* YG; const bf16_t* YC; const float* bglu;
    __device__ __forceinline__ void pair(int row, int c0, f32x4 v0, f32x4 v1) const {
        const f32x4 y0 = unpack4(*(const u32x2*)(YC + (size_t)row * 512 + c0)), y1 = unpack4(*(const u32x2*)(YC + (size_t)row * 512 + c0 + 16));
        const f32x4 b0 = *(const f32x4*)(bglu + c0), b1 = *(const f32x4*)(bglu + c0 + 16); f32x4 a, b;
#pragma unroll
        for (int i = 0; i < 4; ++i) { a[i] = y0[i] * sigmoidf_(v0[i] + b0[i]); b[i] = y1[i] * sigmoidf_(v1[i] + b1[i]); }
        *(u32x2*)(YG + (size_t)row * 512 + c0) = pack4(a); *(u32x2*)(YG + (size_t)row * 512 + c0 + 16) = pack4(b); } };
struct EpiMerge { bf16_t* MX; const bf16_t* SG; int gi; int first;
    __device__ __forceinline__ void pair(int row, int c0, f32x4 v0, f32x4 v1) const {
        const bf16_t* sg = SG + (size_t)row * 3072 + gi * 1024 + c0; bf16_t* mx = MX + (size_t)row * DM + c0;
        f32x4 a = unpack4(*(const u32x2*)sg) * v0, b = unpack4(*(const u32x2*)(sg + 16)) * v1;
        if (!first) { a = a + unpack4(*(const u32x2*)mx); b = b + unpack4(*(const u32x2*)(mx + 16)); }
        *(u32x2*)mx = pack4(a); *(u32x2*)(mx + 16) = pack4(b); } };

template <class Epi>
__device__ __forceinline__ void gemm_simple(const bf16_t* A, int lda, const bf16_t* Bt, int K, int Mr, int Nc, const Epi& E) {
    const int lane = threadIdx.x & 63, wid = threadIdx.x >> 6, fr = lane & 15, fq = lane >> 4;
    const int gw = blockIdx.x * 8 + wid, NGW = gridDim.x * 8, nct = Nc / 64, nit = (Mr / 32) * nct;
    for (int it = gw; it < nit; it += NGW) {
        const int rt = it / nct, ct = it % nct;
        f32x4 acc[2][4];
#pragma unroll
        for (int m = 0; m < 2; ++m)
#pragma unroll
            for (int n = 0; n < 4; ++n) acc[m][n] = (f32x4){0.f, 0.f, 0.f, 0.f};
        const bf16_t* ap = A + (size_t)(rt * 32 + fr) * lda + 8 * fq;
        const bf16_t* bp = Bt + (size_t)(ct * 64 + fr) * K + 8 * fq;
        for (int k0 = 0; k0 < K; k0 += 32) {
            bf16x8 a[2], b[4];
#pragma unroll
            for (int m = 0; m < 2; ++m) a[m] = *(const bf16x8*)(ap + (size_t)m * 16 * lda + k0);
#pragma unroll
            for (int n = 0; n < 4; ++n) b[n] = *(const bf16x8*)(bp + (size_t)n * 16 * K + k0);
#pragma unroll
            for (int m = 0; m < 2; ++m)
#pragma unroll
                for (int n = 0; n < 4; ++n) acc[m][n] = __builtin_amdgcn_mfma_f32_16x16x32_bf16(b[n], a[m], acc[m][n], 0, 0, 0);
        }
#pragma unroll
        for (int m = 0; m < 2; ++m)
#pragma unroll
            for (int np = 0; np < 2; ++np) E.pair(rt * 32 + m * 16 + fr, ct * 64 + np * 32 + 4 * fq, acc[m][2 * np], acc[m][2 * np + 1]);
    }
}
template <class Epi>
__device__ __forceinline__ void gemm_meta(const bf16_t* A, int lda, const bf16_t* Bt, int K, int Nc, const Epi& E, float* red) {
    const int lane = threadIdx.x & 63, wid = threadIdx.x >> 6, fr = lane & 15, fq = lane >> 4;
    __syncthreads();
    for (int cg = (int)blockIdx.x; cg < Nc / 32; cg += (int)gridDim.x) {
        f32x4 a0 = (f32x4){0.f, 0.f, 0.f, 0.f}, a1 = a0;
        const bf16_t* ap = A + (size_t)fr * lda + 8 * fq;
        const bf16_t* bp = Bt + (size_t)(cg * 32 + fr) * K + 8 * fq;
        for (int ks = wid; ks < K / 32; ks += 8) {
            const bf16x8 a = *(const bf16x8*)(ap + ks * 32);
            const bf16x8 b0 = *(const bf16x8*)(bp + ks * 32), b1 = *(const bf16x8*)(bp + (size_t)16 * K + ks * 32);
            a0 = __builtin_amdgcn_mfma_f32_16x16x32_bf16(b0, a, a0, 0, 0, 0);
            a1 = __builtin_amdgcn_mfma_f32_16x16x32_bf16(b1, a, a1, 0, 0, 0);
        }
        *(f32x4*)(red + (wid * 64 + lane) * 8) = a0; *(f32x4*)(red + (wid * 64 + lane) * 8 + 4) = a1;
        __syncthreads();
        if (wid == 0) {
            f32x4 s0 = (f32x4){0.f, 0.f, 0.f, 0.f}, s1 = s0;
#pragma unroll
            for (int w = 0; w < 8; ++w) { s0 = s0 + *(const f32x4*)(red + (w * 64 + lane) * 8); s1 = s1 + *(const f32x4*)(red + (w * 64 + lane) * 8 + 4); }
            E.pair(fr, cg * 32 + 4 * fq, s0, s1);
        }
        __syncthreads();
    }
}

namespace pg8 {
#define PG8_LAS __attribute__((address_space(3)))
typedef unsigned short bf16_t;
typedef short bf16x8 __attribute__((ext_vector_type(8)));
typedef float f32x4 __attribute__((ext_vector_type(4)));
typedef unsigned u32x4 __attribute__((ext_vector_type(4)));
constexpr int BM = 256, BK = 64, HALF = 128, HTB = HALF * BK * 2  , STAGE_BYTES = 8 * HTB, NXCD = 8, WGM = 8;

__host__ __device__ __forceinline__ int lds_byte(int r, int c) { const int st = (r >> 4) * 2 + (c >> 5), rr = r & 15, cc = c & 31, ob = rr * 64 + cc * 2; return st * 1024 + (ob ^ (((ob >> 9) & 1) << 5)); }
__host__ __device__ __forceinline__ void stage_rc(int b, int& R, int& C) { const int st = b / 1024, sb = b % 1024, swz = sb ^ (((sb >> 9) & 1) << 5); R = (st >> 1) * 16 + swz / 64; C = (st & 1) * 32 + (swz % 64) / 2; }
__host__ __device__ __forceinline__ int perm32(int rho) { const int n = rho >> 4, i = rho & 15; return 8 * (i >> 2) + 4 * n + (i & 3); }

struct Unit { int pm, pn; };
struct Gemm { const bf16_t* A; const bf16_t* Bt; int M, N, K, lda; };

struct StaticOrder {
    int nM, nN, nwg, G, c;
    __host__ __device__ void init(int M, int N, int G_, int c_) { nM = M / BM; nN = N / BM; nwg = nM * nN; G = G_; c = c_; }
    __host__ __device__ bool next(int i, Unit& u) const {
        const long L = (long)i * G + c; if (L >= nwg) return false;
        int wgid = (int)L; { const int q = nwg / NXCD, r = nwg % NXCD, xcd = wgid % NXCD, off = wgid / NXCD; wgid = (xcd < r ? xcd * (q + 1) : r * (q + 1) + (xcd - r) * q) + off; }
        const int nig = WGM * nN, gid = wgid / nig, fm = gid * WGM, gsz = (nM - fm) < WGM ? (nM - fm) : WGM;
        u.pm = fm + ((wgid % nig) % gsz); u.pn = (wgid % nig) / gsz; return true;
    }
    __device__ __forceinline__ void a_ready(const Unit&) const {}
    __device__ __forceinline__ void done(const Unit&) const {}
};


template <class F> struct EpiPair {
    static constexpr bool PERM = false, AFTER_DRAIN = false; F f;
    __device__ __forceinline__ void operator()(const f32x4 (&acc)[2][2][4][2], const Unit& u, int wr, int wc, int fr, int fq) const {
#pragma unroll
        for (int ai = 0; ai < 2; ++ai)
#pragma unroll
            for (int m = 0; m < 4; ++m) {
#pragma unroll
                for (int bj = 0; bj < 2; ++bj) f.pair(u.pm * BM + ai * HALF + wr * 64 + m * 16 + fr, u.pn * BM + bj * HALF + wc * 32 + 4 * fq, acc[ai][bj][m][0], acc[ai][bj][m][1]);
                asm volatile("" ::: "memory"); }
    }
};
template <class Epi, class Sched, bool ALIGN_EPI = false, bool SP2 = false>
__device__ __forceinline__ void gemm_phase(PG8_LAS unsigned char* lds, const Gemm g, const Sched& S, const Epi& E) {
    const int tid = threadIdx.x, wid = __builtin_amdgcn_readfirstlane(tid >> 6), lane = tid & 63, wr = wid >> 2, wc = wid & 3, fr = lane & 15, fq = lane >> 4;
    const int K = g.K, nt = K / BK;
    unsigned voffA[2], voffB[2];
#pragma unroll
    for (int i = 0; i < 2; ++i) { int R, C; stage_rc(tid * 16 + i * 8192, R, C); const int Rb = Epi::PERM ? ((R & ~31) + perm32(R & 31)) : R;
        voffA[i] = (unsigned)(R * g.lda + C) * 2u; voffB[i] = (unsigned)(Rb * K + C) * 2u; }
    const size_t kstep = (size_t)(BK * 2);
    const size_t hstepA = (size_t)HALF * g.lda * 2, hstepB = (size_t)HALF * K * 2;
    const size_t tstepA = 2 * hstepA, tstepB = 2 * hstepB;
    const unsigned ldsw = (unsigned)wid * 1024u;
    const int aoff = lds_byte(wr * 64 + fr, fq * 8), boff = lds_byte(wc * 32 + fr, fq * 8);
#define PG8_SA(b, h) (((b) * 2 + (h)) * HTB)
#define PG8_SB(b, h) ((4 + (b) * 2 + (h)) * HTB)
#define PG8_STAGE(bufoff, gbase, voff) do { _Pragma("unroll") for (int _i = 0; _i < 2; ++_i) \
        __builtin_amdgcn_global_load_lds((const unsigned*)((const char*)(gbase) + (voff)[_i]), (PG8_LAS unsigned*)(lds + (bufoff) + ldsw + _i * 8192), 16, 0, 0); } while (0)
#define PG8_LDA(dst, b, h) do { _Pragma("unroll") for (int m = 0; m < 4; ++m) _Pragma("unroll") for (int k = 0; k < 2; ++k) dst[m][k] = *(const PG8_LAS bf16x8*)(lds + PG8_SA(b, h) + aoff + m * 2048 + k * 1024); } while (0)
#define PG8_LDB(dst, b, h) do { _Pragma("unroll") for (int n = 0; n < 2; ++n) _Pragma("unroll") for (int k = 0; k < 2; ++k) dst[n][k] = *(const PG8_LAS bf16x8*)(lds + PG8_SB(b, h) + boff + n * 2048 + k * 1024); } while (0)
#define PG8_MMA(ai, bj, At, Bt) do { __builtin_amdgcn_s_setprio(1); _Pragma("unroll") for (int m = 0; m < 4; ++m) _Pragma("unroll") for (int n = 0; n < 2; ++n) _Pragma("unroll") for (int k = 0; k < 2; ++k) \
        acc[ai][bj][m][n] = __builtin_amdgcn_mfma_f32_16x16x32_bf16(Bt[n][k], At[m][k], acc[ai][bj][m][n], 0, 0, 0); __builtin_amdgcn_s_setprio(0); } while (0)
#define PG8_WAIT_V(n) asm volatile("s_waitcnt vmcnt(" #n ")" ::: "memory")
#define PG8_WAIT_L(n) asm volatile("s_waitcnt lgkmcnt(" #n ")" ::: "memory")
#define PG8_BAR __builtin_amdgcn_s_barrier()
#define PG8_SCHED __builtin_amdgcn_sched_barrier(0)
    Unit cur, nxt; int ui = 0;
    if (!S.next(0, cur)) return;
    f32x4 acc[2][2][4][2];
#pragma unroll
    for (int a = 0; a < 2; ++a)
#pragma unroll
        for (int b = 0; b < 2; ++b)
#pragma unroll
            for (int m = 0; m < 4; ++m)
#pragma unroll
                for (int n = 0; n < 2; ++n) acc[a][b][m][n] = (f32x4){0.f, 0.f, 0.f, 0.f};
    bf16x8 At[4][2], B0[2][2], B1[2][2];
    const char* cA = (const char*)g.A + (size_t)cur.pm * tstepA; const char* cB = (const char*)g.Bt + (size_t)cur.pn * tstepB;
    S.a_ready(cur);
    if constexpr (SP2) {
        PG8_STAGE(PG8_SB(0, 0), cB, voffB); PG8_STAGE(PG8_SB(0, 1), cB + hstepB, voffB); PG8_STAGE(PG8_SA(0, 0), cA, voffA); PG8_STAGE(PG8_SA(0, 1), cA + hstepA, voffA);
        if (wr == 1) PG8_BAR;
        PG8_WAIT_V(2); PG8_BAR;
        PG8_STAGE(PG8_SB(1, 0), cB + kstep, voffB); PG8_STAGE(PG8_SA(1, 0), cA + kstep, voffA); PG8_STAGE(PG8_SB(1, 1), cB + hstepB + kstep, voffB);
        PG8_WAIT_V(6); PG8_BAR;
    } else {
        PG8_STAGE(PG8_SB(0, 0), cB, voffB); PG8_STAGE(PG8_SA(0, 0), cA, voffA); PG8_STAGE(PG8_SB(0, 1), cB + hstepB, voffB); PG8_STAGE(PG8_SA(0, 1), cA + hstepA, voffA);
        if (wr == 1) PG8_BAR;
        PG8_WAIT_V(4); PG8_BAR;
        PG8_STAGE(PG8_SB(1, 0), cB + kstep, voffB); PG8_STAGE(PG8_SA(1, 0), cA + kstep, voffA); PG8_STAGE(PG8_SB(1, 1), cB + hstepB + kstep, voffB);
        PG8_WAIT_V(6); PG8_BAR;
    }
    for (;;) {
        const bool has_next = S.next(ui + 1, nxt);
        const char* nA = has_next ? (const char*)g.A + (size_t)nxt.pm * tstepA : cA; const char* nB = has_next ? (const char*)g.Bt + (size_t)nxt.pn * tstepB : cB;
#pragma nounroll
        for (int t = 0; t < nt; t += 2) {
            const bool last = (t == nt - 2);
            const char* a1 = cA + (size_t)(t + 1) * kstep;
            const char* a2 = last ? nA : cA + (size_t)(t + 2) * kstep; const char* b2 = last ? nB : cB + (size_t)(t + 2) * kstep;
            const char* a3 = a2 + kstep; const char* b3 = b2 + kstep;
            if (last && has_next) S.a_ready(nxt);
            if constexpr (SP2) {
            PG8_LDB(B0, 0, 0); PG8_LDB(B1, 0, 1); PG8_SCHED; PG8_LDA(At, 0, 0); PG8_STAGE(PG8_SA(1, 1), a1 + hstepA, voffA);
            PG8_WAIT_V(8); PG8_WAIT_L(0); PG8_BAR; PG8_MMA(0, 0, At, B0); PG8_MMA(0, 1, At, B1); PG8_BAR; PG8_SCHED;
            PG8_LDA(At, 0, 1); PG8_STAGE(PG8_SB(0, 0), b2, voffB); PG8_STAGE(PG8_SB(0, 1), b2 + hstepB, voffB); PG8_STAGE(PG8_SA(0, 0), a2, voffA);
            PG8_WAIT_V(8); PG8_WAIT_L(0); PG8_BAR; PG8_MMA(1, 0, At, B0); PG8_MMA(1, 1, At, B1); PG8_BAR; PG8_SCHED;
            PG8_LDB(B0, 1, 0); PG8_LDB(B1, 1, 1); PG8_SCHED; PG8_LDA(At, 1, 0); PG8_STAGE(PG8_SA(0, 1), a2 + hstepA, voffA);
            PG8_WAIT_V(8); PG8_WAIT_L(0); PG8_BAR; PG8_MMA(0, 0, At, B0); PG8_MMA(0, 1, At, B1); PG8_BAR; PG8_SCHED;
            PG8_LDA(At, 1, 1); PG8_STAGE(PG8_SB(1, 0), b3, voffB); PG8_STAGE(PG8_SB(1, 1), b3 + hstepB, voffB); PG8_STAGE(PG8_SA(1, 0), a3, voffA);
            PG8_WAIT_V(8); PG8_WAIT_L(0); PG8_BAR; PG8_MMA(1, 0, At, B0); PG8_MMA(1, 1, At, B1); PG8_BAR; PG8_SCHED;
            } else {
            PG8_LDB(B0, 0, 0); PG8_SCHED; PG8_LDA(At, 0, 0); PG8_STAGE(PG8_SA(1, 1), a1 + hstepA, voffA);
            PG8_WAIT_L(8); PG8_BAR; PG8_WAIT_L(0); PG8_MMA(0, 0, At, B0); PG8_BAR; PG8_SCHED;
            PG8_LDB(B1, 0, 1); PG8_STAGE(PG8_SB(0, 0), b2, voffB);
            PG8_BAR; PG8_WAIT_L(0); PG8_MMA(0, 1, At, B1); PG8_BAR;
            PG8_LDA(At, 0, 1); PG8_STAGE(PG8_SA(0, 0), a2, voffA);
            PG8_BAR; PG8_WAIT_L(0); PG8_MMA(1, 0, At, B0); PG8_BAR; PG8_SCHED;
            PG8_STAGE(PG8_SB(0, 1), b2 + hstepB, voffB);
            PG8_WAIT_V(6); PG8_BAR; PG8_MMA(1, 1, At, B1); PG8_BAR;
            PG8_LDB(B0, 1, 0); PG8_SCHED; PG8_LDA(At, 1, 0); PG8_STAGE(PG8_SA(0, 1), a2 + hstepA, voffA);
            PG8_WAIT_L(8); PG8_BAR; PG8_WAIT_L(0); PG8_MMA(0, 0, At, B0); PG8_BAR; PG8_SCHED;
            PG8_LDB(B1, 1, 1); PG8_STAGE(PG8_SB(1, 0), b3, voffB);
            PG8_BAR; PG8_WAIT_L(0); PG8_MMA(0, 1, At, B1); PG8_BAR;
            PG8_LDA(At, 1, 1); PG8_STAGE(PG8_SA(1, 0), a3, voffA);
            PG8_BAR; PG8_WAIT_L(0); PG8_MMA(1, 0, At, B0); PG8_BAR; PG8_SCHED;
            PG8_STAGE(PG8_SB(1, 1), b3 + hstepB, voffB);
            PG8_WAIT_V(6); PG8_BAR; PG8_MMA(1, 1, At, B1); PG8_BAR;
            }
        }
        if constexpr (ALIGN_EPI) { if (wr == 0) PG8_BAR; }
        if constexpr (!Epi::AFTER_DRAIN) { E(acc, cur, wr, wc, fr, fq); S.done(cur); }
        if (!has_next) break;
#pragma unroll
        for (int a = 0; a < 2; ++a)
#pragma unroll
            for (int b = 0; b < 2; ++b)
#pragma unroll
                for (int m = 0; m < 4; ++m)
#pragma unroll
                    for (int n = 0; n < 2; ++n) acc[a][b][m][n] = (f32x4){0.f, 0.f, 0.f, 0.f};
        cur = nxt; cA = nA; cB = nB; ++ui;
        if constexpr (ALIGN_EPI) { if (wr == 1) PG8_BAR; }
    }
    PG8_WAIT_V(0);
    if constexpr (!ALIGN_EPI) { if (wr == 0) PG8_BAR; }
    PG8_BAR;
    if constexpr (Epi::AFTER_DRAIN) { E.fused(acc, cur, wr, wc, fr, fq, lds, wid, lane); S.done(cur); }
#undef PG8_SA
#undef PG8_SB
#undef PG8_STAGE
#undef PG8_LDA
#undef PG8_LDB
#undef PG8_MMA
#undef PG8_WAIT_V
#undef PG8_WAIT_L
#undef PG8_BAR
#undef PG8_SCHED
}
}

template <class F> __device__ __forceinline__ void gemm_eng(unsigned char* lds, const bf16_t* A, int lda, const bf16_t* Bt, int K, int N, const F& f) {
    __syncthreads();
    pg8::Gemm g{A, Bt, MROWS, N, K, lda}; pg8::StaticOrder S; S.init(MROWS, N, (int)gridDim.x, (int)blockIdx.x);
    pg8::EpiPair<F> E{f};
    pg8::gemm_phase<pg8::EpiPair<F>, pg8::StaticOrder, true, true>((LAS unsigned char*)lds, g, S, E);
}

struct WDesc { const float* src0; const float* src1; int srcN; int K; bf16_t* dst; int rows; int kind; int coff; int nvalid; const float* scale; };
__device__ __forceinline__ void cvt_weight(const WDesc& d, float* scr_all) {
    const int lane = threadIdx.x & 63, wid = threadIdx.x >> 6;
    float* scr = scr_all + wid * (64 * 33);
    const int gw = blockIdx.x * 8 + wid, NGW = gridDim.x * 8, nblk = d.rows / 32, nit = (d.K / 64) * nblk;
    for (int it = gw; it < nit; it += NGW) {
        const int kb = it / nblk, nb = it % nblk, k0 = 64 * kb, n0 = 32 * nb;
        const int r = n0 + (lane & 31);
        const float* src = d.src0; int col = 0; bool valid = true;
        if (d.kind == 0) { valid = r < d.nvalid; col = d.coff + r; }
        else if (d.kind == 1) { const int q = r >> 5, w = r & 31; src = (w < 16) ? d.src0 : d.src1; col = 16 * q + (w & 15); }
        else { if (r < 512) col = (r >> 6) * 96 + (r & 63); else col = ((r - 512) >> 5) * 96 + 64 + ((r - 512) & 31); }
#pragma unroll 8
        for (int i = 0; i < 32; ++i) { const int kk = 2 * i + (lane >> 5);
            float v = valid ? src[(size_t)(k0 + kk) * d.srcN + col] : 0.f; if (d.scale) v *= d.scale[k0 + kk];
            scr[kk * 33 + (lane & 31)] = v; }
        const int c8 = lane & 7;
#pragma unroll
        for (int j = 0; j < 4; ++j) { const int n = (lane >> 3) + 8 * j; const float* s = scr + (8 * c8) * 33 + n;
            u32x4 o; o.x = pk2(s[0], s[33]); o.y = pk2(s[66], s[99]); o.z = pk2(s[132], s[165]); o.w = pk2(s[198], s[231]);
            *(u32x4*)(d.dst + (size_t)(n0 + n) * d.K + k0 + 8 * c8) = o; }
    }
}
__device__ __forceinline__ bf16_t* slot_ptr(const Args& a, int gp) { return (bf16_t*)(a.ws() + ((gp & 1) ? WS_SLOT1 : WS_SLOT0)); }
__device__ __forceinline__ void convert_phase(const Args& a, int l, int p, float* scr) {
    if (l > 1) return;
    __syncthreads();
    bf16_t* S = slot_ptr(a, 9 * l + p);
    WDesc d; d.src1 = nullptr; d.kind = 0; d.coff = 0; d.scale = nullptr;
    if (p == 1 || p == 8) {
        d.src0 = ((p == 1) ? a.in(I_F1G) : a.in(I_F2G)) + (size_t)l * DM * DFF; d.src1 = ((p == 1) ? a.in(I_F1U) : a.in(I_F2U)) + (size_t)l * DM * DFF; d.srcN = DFF; d.K = DM; d.dst = S; d.rows = NGU; d.kind = 1; d.nvalid = NGU; cvt_weight(d, scr); }
    else if (p == 2 || p == 9) {
        d.src0 = ((p == 2) ? a.in(I_F1D) : a.in(I_F2D)) + (size_t)l * DFF * DM; d.srcN = DM; d.K = DFF; d.dst = S; d.rows = DM; d.nvalid = DM; cvt_weight(d, scr); }
    else if (p == 3) { d.src0 = a.in(I_WIN) + (size_t)l * DM * DIN; d.srcN = DIN; d.K = DM; d.dst = S; d.rows = PA_N; d.nvalid = OFF_GATES; cvt_weight(d, scr); }
    else if (p == 4) {
        d.src0 = a.in(I_WUQ) + (size_t)l * 384 * 768; d.srcN = 768; d.K = 384; d.dst = S; d.rows = 768; d.kind = 2; d.nvalid = 768; d.scale = a.in(I_QNG) + l * 384; cvt_weight(d, scr);
        d.src0 = a.in(I_WUKV) + (size_t)l * 256 * 1024; d.srcN = 1024; d.K = 256; d.dst = S + (1 * MiB) / 2; d.rows = 1024; d.kind = 0; d.nvalid = 1024; d.scale = a.in(I_KVNG) + l * 256; cvt_weight(d, scr); }
    else if (p == 5) {
        d.src0 = a.in(I_WIN) + (size_t)l * DM * DIN; d.srcN = DIN; d.K = DM; d.dst = S; d.rows = 3072; d.coff = OFF_GATES; d.nvalid = 3072; cvt_weight(d, scr);
        d.src0 = a.in(I_WGLU) + (size_t)l * 512 * 512; d.srcN = 512; d.K = 512; d.dst = S + (8 * MiB) / 2; d.rows = 512; d.coff = 0; d.nvalid = 512; cvt_weight(d, scr); }
    else if (p == 6) {
        d.srcN = DM; d.K = 512; d.rows = DM; d.nvalid = DM;
        d.src0 = a.in(I_WOA) + (size_t)l * 512 * DM; d.dst = S; cvt_weight(d, scr);
        d.src0 = a.in(I_WOB) + (size_t)l * 512 * DM; d.dst = S + (1 * MiB) / 2; cvt_weight(d, scr);
        d.src0 = a.in(I_WOC) + (size_t)l * 512 * DM; d.dst = S + (2 * MiB) / 2; cvt_weight(d, scr); }
    else if (p == 7) { d.src0 = a.in(I_WO) + (size_t)l * DM * DM; d.srcN = DM; d.K = DM; d.dst = S; d.rows = DM; d.nvalid = DM; cvt_weight(d, scr); }
}
__device__ __forceinline__ void convert_next(const Args& a, int l, int p, float* scr) { if (p == 9) convert_phase(a, l + 1, 1, scr); else convert_phase(a, l, p + 1, scr); }

__device__ __forceinline__ void ln_row(float* xrow, bf16_t* orow, const float* g, const float* b, int lane) {
    f32x4 v[4]; float s = 0.f;
#pragma unroll
    for (int j = 0; j < 4; ++j) { v[j] = *(const f32x4*)(xrow + 4 * lane + 256 * j); s += (v[j][0] + v[j][1]) + (v[j][2] + v[j][3]); }
    const float mean = wave_sum(s) * (1.f / DM); float s2 = 0.f;
#pragma unroll
    for (int j = 0; j < 4; ++j) { v[j] = v[j] - mean; s2 += (v[j][0] * v[j][0] + v[j][1] * v[j][1]) + (v[j][2] * v[j][2] + v[j][3] * v[j][3]); }
    const float rstd = rsqrtf(wave_sum(s2) * (1.f / DM) + LN_EPS);
#pragma unroll
    for (int j = 0; j < 4; ++j) { const f32x4 gg = *(const f32x4*)(g + 4 * lane + 256 * j), bb = *(const f32x4*)(b + 4 * lane + 256 * j);
        const f32x4 o = v[j] * rstd * gg + bb; *(f32x4*)(xrow + 4 * lane + 256 * j) = o; *(u32x2*)(orow + 4 * lane + 256 * j) = pack4(o); }
}
__device__ __forceinline__ void stage_ln(const Args& a, const float* g, const float* b) {
    const int lane = threadIdx.x & 63, gw = blockIdx.x * 8 + (threadIdx.x >> 6), NGW = gridDim.x * 8;
    float* Xm = (float*)(a.ws() + WS_META + MT_X); bf16_t* XNm = (bf16_t*)(a.ws() + WS_META + MT_XN); bf16_t* XN = (bf16_t*)(a.ws() + WS_XN);
    for (int r = gw; r < MROWS + NMETA; r += NGW) {
        if (r < MROWS) ln_row(a.out() + (size_t)r * DM, XN + (size_t)r * DM, g, b, lane);
        else ln_row(Xm + (size_t)(r - MROWS) * DM, XNm + (size_t)(r - MROWS) * DM, g, b, lane);
    }
}
__device__ __forceinline__ void stage_prologue(const Args& a, float* scr) {
    const int tid = threadIdx.x, gt = blockIdx.x * 512 + tid, NGT = gridDim.x * 512;
    bf16_t* XN = (bf16_t*)(a.ws() + WS_XN); float* Xm = (float*)(a.ws() + WS_META + MT_X); bf16_t* XNm = (bf16_t*)(a.ws() + WS_META + MT_XN);
    const float* x = a.in(I_X);
    for (size_t i = gt; i < (size_t)MROWS * DM / 8; i += NGT) { const f32x4 p = *(const f32x4*)(x + i * 8), q = *(const f32x4*)(x + i * 8 + 4);
        u32x4 o; o.x = pk2(p[0], p[1]); o.y = pk2(p[2], p[3]); o.z = pk2(q[0], q[1]); o.w = pk2(q[2], q[3]); *(u32x4*)(XN + i * 8) = o; }
    for (int i = gt; i < NMETA * DM; i += NGT) { const float v = a.in(I_META)[i]; Xm[i] = v; XNm[i] = (bf16_t)f2bf(v); }
    float* rc = (float*)(a.ws() + WS_TAB + TAB_COS); float* rs = (float*)(a.ws() + WS_TAB + TAB_SIN);
    for (int i = gt; i < (SEQ + NMETA) * 16; i += NGT) { const int pos = i >> 4, j = i & 15; const double inv = pow(10000.0, -(double)j / 16.0), ang = (double)pos * inv; rc[i] = (float)cos(ang); rs[i] = (float)sin(ang); }
    float* AB = (float*)(a.ws() + WS_TAB + TAB_AB); float* BBR = (float*)(a.ws() + WS_TAB + TAB_BBR); float* BBI = (float*)(a.ws() + WS_TAB + TAB_BBI);
    for (int i = gt; i < 2 * 32 * 64; i += NGT) {
        const int lg = i >> 6; const double are = a.in(I_SARE)[i], aim = a.in(I_SAIM)[i], dt = exp((double)a.in(I_SLDT)[lg]);
        const double mag = exp(dt * are), abr = mag * cos(dt * aim), abi = mag * sin(dt * aim), den = are * are + aim * aim, nr = abr - 1.0, ni = abi;
        const double cr = (nr * are + ni * aim) / den, ci = (ni * are - nr * aim) / den;
        AB[2 * i] = (float)abr; AB[2 * i + 1] = (float)abi;
        for (int h = 0; h < 16; ++h) { const double br = a.in(I_SBRE)[(size_t)i * 16 + h], bi = a.in(I_SBIM)[(size_t)i * 16 + h];
            BBR[(size_t)i * 16 + h] = (float)(cr * br - ci * bi); BBI[(size_t)i * 16 + h] = (float)(cr * bi + ci * br); } }
    convert_phase(a, 0, 1, scr);
}
__device__ __forceinline__ void stage_krope_pad(const Args& a) {
    const int gt = blockIdx.x * 512 + threadIdx.x, NGT = gridDim.x * 512;
    const bf16_t* PA = (const bf16_t*)(a.ws() + WS_R1); const bf16_t* PM = (const bf16_t*)(a.ws() + WS_META + MT_PROJ);
    bf16_t* KR = (bf16_t*)(a.ws() + WS_KR); bf16_t* KV = (bf16_t*)(a.ws() + WS_KV);
    const float* rc = (const float*)(a.ws() + WS_TAB + TAB_COS); const float* rs = (const float*)(a.ws() + WS_TAB + TAB_SIN);
    for (int i = gt; i < (MROWS + NMETA) * 16; i += NGT) { const int r = i >> 4, j = i & 15;
        if (r < MROWS) { const int pos = 16 + (r & 2047); const bf16_t* p = PA + (size_t)r * PA_N + OFF_KR; const float x1 = bf2f(p[j]), x2 = bf2f(p[j + 16]), c = rc[pos * 16 + j], s = rs[pos * 16 + j];
            bf16_t* o = KR + ((size_t)r + 64 * (r >> 11) + 16) * 32; o[j] = (bf16_t)f2bf(x1 * c - x2 * s); o[j + 16] = (bf16_t)f2bf(x2 * c + x1 * s); }
        else { const int pos = r - MROWS; const bf16_t* p = PM + (size_t)pos * PA_N + OFF_KR; const float x1 = bf2f(p[j]), x2 = bf2f(p[j + 16]), c = rc[pos * 16 + j], s = rs[pos * 16 + j];
            const bf16_t o1 = (bf16_t)f2bf(x1 * c - x2 * s), o2 = (bf16_t)f2bf(x2 * c + x1 * s);
            for (int b = 0; b < NB; ++b) { bf16_t* o = KR + ((size_t)b * LPAD + pos) * 32; o[j] = o1; o[j + 16] = o2; } } }
    for (int i = gt; i < NB * 48 * 128; i += NGT) { const int b = i / (48 * 128), rem = i % (48 * 128), rr = rem >> 7, c = rem & 127; *(u32x4*)(KV + ((size_t)b * LPAD + 2064 + rr) * 1024 + c * 8) = (u32x4){0u, 0u, 0u, 0u}; }
    for (int i = gt; i < NB * 48 * 4; i += NGT) { const int b = i / (48 * 4), rem = i % (48 * 4), rr = rem >> 2, c = rem & 3; *(u32x4*)(KR + ((size_t)b * LPAD + 2064 + rr) * 32 + c * 8) = (u32x4){0u, 0u, 0u, 0u}; }
}
__device__ __forceinline__ void stage_conv(const Args& a, int l) {
    const int gt = blockIdx.x * 512 + threadIdx.x, NGT = gridDim.x * 512;
    const bf16_t* PA = (const bf16_t*)(a.ws() + WS_R1); const bf16_t* PM = (const bf16_t*)(a.ws() + WS_META + MT_PROJ);
    bf16_t* GB = (bf16_t*)(a.ws() + WS_GB); bf16_t* GBm = (bf16_t*)(a.ws() + WS_META + MT_GB);
    const float* cw = a.in(I_CONVW) + l * 3 * 512; const float* cb = a.in(I_CONVB) + l * 512;
    for (int i = gt; i < (MROWS + NMETA) * 64; i += NGT) { const int r = i >> 6, c = (i & 63) * 8;
        const bf16_t *cur, *p1, *p2; bf16_t* dst;
        if (r < MROWS) { const int t = r & 2047; cur = PA + (size_t)r * PA_N; p1 = (t >= 1) ? cur - PA_N : PM + 15 * PA_N; p2 = (t >= 2) ? cur - 2 * PA_N : (t == 1 ? PM + 15 * PA_N : PM + 14 * PA_N); dst = GB + (size_t)r * 512 + c; }
        else { const int t = r - MROWS; cur = PM + (size_t)t * PA_N; p1 = (t >= 1) ? cur - PA_N : nullptr; p2 = (t >= 2) ? cur - 2 * PA_N : nullptr; dst = GBm + (size_t)t * 512 + c; }
        const u32x4 xb0 = *(const u32x4*)(cur + OFF_XBAR + c), cg0 = *(const u32x4*)(cur + OFF_CG + c), bg = *(const u32x4*)(cur + OFF_BG + c);
        u32x4 xb1 = (u32x4){0u, 0u, 0u, 0u}, cg1 = xb1, xb2 = xb1, cg2 = xb1;
        if (p1) { xb1 = *(const u32x4*)(p1 + OFF_XBAR + c); cg1 = *(const u32x4*)(p1 + OFF_CG + c); }
        if (p2) { xb2 = *(const u32x4*)(p2 + OFF_XBAR + c); cg2 = *(const u32x4*)(p2 + OFF_CG + c); }
        u32x4 o;
#pragma unroll
        for (int q = 0; q < 4; ++q) {
            const int ce = c + 2 * q;
            const float u0l = bflo(cg0[q]) * bflo(xb0[q]), u0h = bfhi(cg0[q]) * bfhi(xb0[q]);
            const float u1l = bflo(cg1[q]) * bflo(xb1[q]), u1h = bfhi(cg1[q]) * bfhi(xb1[q]);
            const float u2l = bflo(cg2[q]) * bflo(xb2[q]), u2h = bfhi(cg2[q]) * bfhi(xb2[q]);
            const float yl = cb[ce] + cw[ce] * u2l + cw[512 + ce] * u1l + cw[1024 + ce] * u0l;
            const float yh = cb[ce + 1] + cw[ce + 1] * u2h + cw[512 + ce + 1] * u1h + cw[1024 + ce + 1] * u0h;
            o[q] = pk2(bflo(bg[q]) * yl, bfhi(bg[q]) * yh); }
        *(u32x4*)dst = o; }
}
__device__ __forceinline__ void stage_s5(const Args& a, int l, unsigned char* lds) {
    float* E = (float*)lds; float* Cp = (float*)(lds + 4096); float* Xs = (float*)(lds + 12288);
    const int tid = threadIdx.x, lane = tid & 63, wid = tid >> 6;
    const bf16_t* PA = (const bf16_t*)(a.ws() + WS_R1); const bf16_t* PM = (const bf16_t*)(a.ws() + WS_META + MT_PROJ);
    bf16_t* YC = (bf16_t*)(a.ws() + WS_YC); bf16_t* YCm = (bf16_t*)(a.ws() + WS_META + MT_YC);
    const float* AB = (const float*)(a.ws() + WS_TAB + TAB_AB); const float* BBR = (const float*)(a.ws() + WS_TAB + TAB_BBR); const float* BBI = (const float*)(a.ws() + WS_TAB + TAB_BBI);
    float* xs = Xs + wid * (16 * 129);
    for (int it = (int)blockIdx.x; it < NB * 32; it += (int)gridDim.x) {
        const int b = it >> 5, g = it & 31, pi_ = (l * 32 + g) * 64 + lane;
        const float abr = AB[2 * pi_], abi = AB[2 * pi_ + 1];
        float br[16], bi[16];
#pragma unroll
        for (int h = 0; h < 16; ++h) { br[h] = BBR[(size_t)pi_ * 16 + h]; bi[h] = BBI[(size_t)pi_ * 16 + h]; }
        __syncthreads();
        for (int idx = tid; idx < 2048; idx += 512) { const int k = idx >> 4, h = idx & 15;
            Cp[idx] = (k < 64) ? a.in(I_SCRE)[((size_t)(l * 32 + g) * 16 + h) * 64 + k] : -a.in(I_SCIM)[((size_t)(l * 32 + g) * 16 + h) * 64 + (k - 64)]; }
        const int uoff = OFF_U + 16 * g;
        const bf16_t* ubase = PA + ((size_t)b * SEQ + 256 * wid) * PA_N + uoff;
        float xr = 0.f, xi = 0.f;
#define S5_STEP(UP) do { const u32x4 w0_ = *(const u32x4*)(UP), w1_ = *(const u32x4*)((UP) + 8); float bur = 0.f, bui = 0.f; \
            _Pragma("unroll") for (int q = 0; q < 4; ++q) { const float ul = bflo(w0_[q]), uh = bfhi(w0_[q]), vl = bflo(w1_[q]), vh = bfhi(w1_[q]); \
                bur += br[2 * q] * ul + br[2 * q + 1] * uh + br[8 + 2 * q] * vl + br[8 + 2 * q + 1] * vh; bui += bi[2 * q] * ul + bi[2 * q + 1] * uh + bi[8 + 2 * q] * vl + bi[8 + 2 * q + 1] * vh; } \
            const float nxr = abr * xr - abi * xi + bur, nxi = abr * xi + abi * xr + bui; xr = nxr; xi = nxi; } while (0)
        if (wid == 0) for (int r = 0; r < NMETA; ++r) S5_STEP(PM + (size_t)r * PA_N + uoff);
        for (int t = 0; t < 256; ++t) S5_STEP(ubase + (size_t)t * PA_N);
        E[(wid * 64 + lane) * 2] = xr; E[(wid * 64 + lane) * 2 + 1] = xi;
        __syncthreads();
        float pr = abr, pim = abi;
#pragma unroll
        for (int s = 0; s < 8; ++s) { const float nr = pr * pr - pim * pim, ni = 2.f * pr * pim; pr = nr; pim = ni; }
        xr = 0.f; xi = 0.f;
        for (int v = 0; v < wid; ++v) { const float er = E[(v * 64 + lane) * 2], ei = E[(v * 64 + lane) * 2 + 1]; const float nr = pr * xr - pim * xi + er, ni = pr * xi + pim * xr + ei; xr = nr; xi = ni; }
        const int tl = lane >> 2, hq = lane & 3;
        const f32x4 dv = *(const f32x4*)(a.in(I_SD) + (size_t)(l * 32 + g) * 16 + 4 * hq);
        for (int sc = (wid == 0 ? -1 : 0); sc < 16; ++sc) {
            const bf16_t* ub = (sc < 0) ? PM + uoff : ubase + (size_t)(16 * sc) * PA_N;
            for (int t = 0; t < 16; ++t) { S5_STEP(ub + (size_t)t * PA_N); xs[t * 129 + lane] = xr; xs[t * 129 + 64 + lane] = xi; }
            f32x4 acc = (f32x4){0.f, 0.f, 0.f, 0.f};
#pragma unroll 8
            for (int k = 0; k < 128; ++k) { const float xv = xs[tl * 129 + k]; const f32x4 cv = *(const f32x4*)(Cp + k * 16 + 4 * hq); acc = acc + cv * xv; }
            const f32x4 uv = unpack4(*(const u32x2*)(ub + (size_t)tl * PA_N + 4 * hq));
            f32x4 y = acc + dv * uv;
#pragma unroll
            for (int i = 0; i < 4; ++i) y[i] = gelu_tanh(y[i]);
            if (sc >= 0) *(u32x2*)(YC + ((size_t)b * SEQ + 256 * wid + 16 * sc + tl) * 512 + 16 * g + 4 * hq) = pack4(y);
            else if (b == 0) *(u32x2*)(YCm + (size_t)tl * 512 + 16 * g + 4 * hq) = pack4(y);
        }
#undef S5_STEP
    }
}
__device__ __forceinline__ void stage_attn_simple(const Args& a) {
    const int lane = threadIdx.x & 63, gw = blockIdx.x * 8 + (threadIdx.x >> 6), NGW = gridDim.x * 8;
    const bf16_t* KV = (const bf16_t*)(a.ws() + WS_KV); const bf16_t* KR = (const bf16_t*)(a.ws() + WS_KR);
    bf16_t* Q = (bf16_t*)(a.ws() + WS_Q); bf16_t* Qm = (bf16_t*)(a.ws() + WS_META + MT_Q);
    constexpr int NMAIN = MROWS * 8;
    for (int it = gw; it < NMAIN + NMETA * 8; it += NGW) {
        int h, pos; bf16_t* qp; size_t kvb;
        if (it < NMAIN) { h = it & 7; const int r = it >> 3; pos = 16 + (r & 2047); qp = Q + (size_t)r * 768; kvb = (size_t)(r >> 11) * LPAD; }
        else { const int j = it - NMAIN; h = j & 7; const int r = j >> 3; pos = r; qp = Qm + (size_t)r * 768; kvb = 0; }
        const float qa = bf2f(qp[h * 64 + lane]); const float qb = bf2f(qp[512 + h * 32 + (lane & 31)]);
        float m = -INFINITY, lsum = 0.f, o = 0.f;
        for (int kc = 0; kc * 64 <= pos; ++kc) {
            const int p = kc * 64 + lane; const bool valid = p <= pos;
            const bf16_t* kp = KV + (kvb + p) * 1024 + h * 128; const bf16_t* rp = KR + (kvb + p) * 32;
            float s = 0.f;
#pragma unroll
            for (int c = 0; c < 8; ++c) { const u32x4 w = *(const u32x4*)(kp + c * 8);
#pragma unroll
                for (int q = 0; q < 4; ++q) { s += __shfl(qa, c * 8 + 2 * q) * bflo(w[q]); s += __shfl(qa, c * 8 + 2 * q + 1) * bfhi(w[q]); } }
#pragma unroll
            for (int c = 0; c < 4; ++c) { const u32x4 w = *(const u32x4*)(rp + c * 8);
#pragma unroll
                for (int q = 0; q < 4; ++q) { s += __shfl(qb, c * 8 + 2 * q) * bflo(w[q]); s += __shfl(qb, c * 8 + 2 * q + 1) * bfhi(w[q]); } }
            s = valid ? s : -INFINITY;
            const float mn = fmaxf(m, wave_max(s)); const float alpha = exp2f(m - mn); const float pj = valid ? exp2f(s - mn) : 0.f;
            lsum = lsum * alpha + wave_sum(pj); o *= alpha; m = mn;
            const int nj = min(64, pos + 1 - kc * 64);
            const bf16_t* vp = KV + (kvb + kc * 64) * 1024 + h * 128 + 64 + lane;
            for (int j = 0; j < nj; ++j) o += __shfl(pj, j) * bf2f(vp[(size_t)j * 1024]);
        }
        qp[h * 64 + lane] = (bf16_t)f2bf(o / lsum);
    }
}

constexpr int N_STAGES = 25;
template <int st> __device__ __forceinline__ void run_stage(unsigned char* lds) {
    int opq; asm volatile("s_mov_b32 %0, 0" : "=s"(opq));
    Args a; a.kp = (const void* CAS const*)__builtin_amdgcn_kernarg_segment_ptr(); a.opq = opq;
    float* scr = (float*)lds;
    unsigned char* ws = a.ws();
    bf16_t* XN = (bf16_t*)(ws + WS_XN); bf16_t* R1 = (bf16_t*)(ws + WS_R1); bf16_t* Q = (bf16_t*)(ws + WS_Q); bf16_t* KV = (bf16_t*)(ws + WS_KV);
    bf16_t* GB = (bf16_t*)(ws + WS_GB); bf16_t* YC = (bf16_t*)(ws + WS_YC); bf16_t* YG = (bf16_t*)(ws + WS_YG); float* SS = (float*)(ws + WS_SS);
    unsigned char* mt = ws + WS_META;
    float* Xm = (float*)(mt + MT_X); bf16_t* XNm = (bf16_t*)(mt + MT_XN); bf16_t* Hm = (bf16_t*)(mt + MT_H); bf16_t* PM = (bf16_t*)(mt + MT_PROJ); bf16_t* Qm = (bf16_t*)(mt + MT_Q);
    bf16_t* GBm = (bf16_t*)(mt + MT_GB); bf16_t* YCm = (bf16_t*)(mt + MT_YC); bf16_t* YGm = (bf16_t*)(mt + MT_YG); bf16_t* SGm = (bf16_t*)(mt + MT_SG); bf16_t* MXm = (bf16_t*)(mt + MT_MIX); float* SSm = (float*)(mt + MT_SS);
    const float* rc = (const float*)(ws + WS_TAB + TAB_COS); const float* rs = (const float*)(ws + WS_TAB + TAB_SIN);
    if (st == 0) { stage_prologue(a, scr); return; }
    constexpr int l = (st - 1) / 12, s = (st - 1) % 12;
    const float* xin = (l == 0) ? a.in(I_X) : a.out();
    if (s == 0 || s == 9) {
        const int p = (s == 0) ? 1 : 8; const bf16_t* W = slot_ptr(a, 9 * l + p);
        gemm_eng(lds, XN, DM, W, DM, NGU, EpiSwiglu{R1, DFF});
        gemm_meta(XNm, DM, W, DM, NGU, EpiSwiglu{Hm, DFF}, scr);
        convert_next(a, l, p, scr);
    } else if (s == 1 || s == 10) {
        const int p = (s == 1) ? 2 : 9; const bf16_t* W = slot_ptr(a, 9 * l + p);
        const float* xi_ = (s == 1) ? xin : a.out();
        gemm_eng(lds, R1, DFF, W, DFF, DM, EpiResid{xi_, a.out(), ALPHA, 0.5f});
        gemm_meta(Hm, DFF, W, DFF, DM, EpiResid{Xm, Xm, ALPHA, 0.5f}, scr);
        convert_next(a, l, p, scr);
    } else if (s == 2) { stage_ln(a, a.in(I_LN1G) + l * DM, a.in(I_LN1B) + l * DM);
    } else if (s == 8) { stage_ln(a, a.in(I_LN2G) + l * DM, a.in(I_LN2B) + l * DM);
    } else if (s == 11) { stage_ln(a, a.in(I_LN3G) + l * DM, a.in(I_LN3B) + l * DM);
    } else if (s == 3) {
        const bf16_t* W = slot_ptr(a, 9 * l + 3);
        gemm_eng(lds, XN, DM, W, DM, PA_N, EpiProjA{R1, SS});
        gemm_meta(XNm, DM, W, DM, PA_N, EpiProjA{PM, SSm}, scr);
        convert_next(a, l, 3, scr);
    } else if (s == 4) {
        const bf16_t* W = slot_ptr(a, 9 * l + 4);
        gemm_eng(lds, R1, PA_N, W, 384, 768, EpiUq{Q, SS, rc, rs, 16, 2047});
        gemm_meta(PM, PA_N, W, 384, 768, EpiUq{Qm, SSm, rc, rs, 0, 15}, scr);
        gemm_eng(lds, R1 + OFF_CKV, PA_N, W + (1 * MiB) / 2, 256, 1024, EpiUkv{KV, SS, 0});
        gemm_meta(PM + OFF_CKV, PA_N, W + (1 * MiB) / 2, 256, 1024, EpiUkv{KV, SSm, 1}, scr);
        stage_krope_pad(a);
        stage_conv(a, l);
        __syncthreads();
        stage_s5(a, l, lds);
        __syncthreads();
        convert_next(a, l, 4, scr);
    } else if (s == 5) {
        const bf16_t* W = slot_ptr(a, 9 * l + 5);
        stage_attn_simple(a);
        gemm_eng(lds, YC, 512, W + (8 * MiB) / 2, 512, 512, EpiGlu{YG, YC, a.in(I_BGLU) + l * 512});
        gemm_meta(YCm, 512, W + (8 * MiB) / 2, 512, 512, EpiGlu{YGm, YCm, a.in(I_BGLU) + l * 512}, scr);
        gemm_eng(lds, XN, DM, W, DM, 3072, EpiSig{R1});
        gemm_meta(XNm, DM, W, DM, 3072, EpiSig{SGm}, scr);
        convert_next(a, l, 5, scr);
    } else if (s == 6) {
        const bf16_t* W = slot_ptr(a, 9 * l + 6);
        gemm_eng(lds, Q, 768, W, 512, DM, EpiMerge{KV, R1, 0, 1});
        gemm_eng(lds, GB, 512, W + (1 * MiB) / 2, 512, DM, EpiMerge{KV, R1, 1, 0});
        gemm_eng(lds, YG, 512, W + (2 * MiB) / 2, 512, DM, EpiMerge{KV, R1, 2, 0});
        gemm_meta(Qm, 768, W, 512, DM, EpiMerge{MXm, SGm, 0, 1}, scr);
        gemm_meta(GBm, 512, W + (1 * MiB) / 2, 512, DM, EpiMerge{MXm, SGm, 1, 0}, scr);
        gemm_meta(YGm, 512, W + (2 * MiB) / 2, 512, DM, EpiMerge{MXm, SGm, 2, 0}, scr);
        convert_next(a, l, 6, scr);
    } else if (s == 7) {
        const bf16_t* W = slot_ptr(a, 9 * l + 7);
        gemm_eng(lds, KV, DM, W, DM, DM, EpiResid{a.out(), a.out(), ALPHA, 1.0f});
        gemm_meta(MXm, DM, W, DM, DM, EpiResid{Xm, Xm, ALPHA, 1.0f}, scr);
        convert_next(a, l, 7, scr);
    }
}

#define XB_TMO      128
#define XB_XCNT(j)  (256  + 64 * (j))
#define XB_XSUB(j)  (1280 + 64 * (j))
#define XB_XGEN(j)  (2304 + 64 * (j))
#define XB_TOP      3328
#define XB_TOPGEN   3392
#define XCD_BAR_WORDS 3456
#define XB_SPIN_CAP (1u << 18)
__device__ __forceinline__ unsigned xb_ld(unsigned* p)              { return __hip_atomic_load(p, __ATOMIC_RELAXED, __HIP_MEMORY_SCOPE_AGENT); }
__device__ __forceinline__ unsigned xb_add(unsigned* p, unsigned v) { return __hip_atomic_fetch_add(p, v, __ATOMIC_RELAXED, __HIP_MEMORY_SCOPE_AGENT); }
__device__ __forceinline__ unsigned xb_xcc_id() { return (unsigned)__builtin_amdgcn_s_getreg((3 << 11) | 20) & 0xFu; }
#define XB_SPIN(cond, bar) do { unsigned _sp = 0; while (cond) { __builtin_amdgcn_s_sleep(1); \
    if ((++_sp & 255u) == 0u) { if (xb_ld(&(bar)[XB_TMO])) break; if (_sp > XB_SPIN_CAP) { atomicAdd(&(bar)[XB_TMO], 1u); break; } } } } while (0)
struct XcdBarrier { unsigned* bar; unsigned x; volatile LAS unsigned* st; };
__device__ __forceinline__ XcdBarrier xcd_barrier_post(unsigned* bar, volatile LAS unsigned* st) {
    XcdBarrier b; b.bar = bar; b.x = xb_xcc_id(); b.st = st;
    if (threadIdx.x == 0) (void)xb_add(&bar[XB_XCNT(b.x)], 1u);
    return b;
}
__device__ __forceinline__ void xcd_barrier_complete(unsigned* bar, unsigned x, unsigned& nloc, unsigned& nx) {
    const unsigned G = gridDim.x * gridDim.y * gridDim.z;
    unsigned sum, cnt, mine, sp = 0u;
    for (;;) {
        sum = 0u; cnt = 0u; mine = 0u;
#pragma unroll
        for (unsigned j = 0; j < 16; ++j) { const unsigned c = xb_ld(&bar[XB_XCNT(j)]); sum += c; cnt += (c > 0u) ? 1u : 0u; mine = (j == x) ? c : mine; }
        if (sum == G) break;
        __builtin_amdgcn_s_sleep(1);
        if ((++sp & 255u) == 0u) { if (xb_ld(&bar[XB_TMO])) break; if (sp > XB_SPIN_CAP) { atomicAdd(&bar[XB_TMO], 1u); break; } }
    }
    nloc = mine > 0u ? mine : 1u; nx = cnt > 0u ? cnt : 1u;
}
__device__ __forceinline__ void xcd_barrier(const XcdBarrier& b) {
    asm volatile("s_waitcnt vmcnt(0)" ::: "memory");
    __syncthreads();
    if (threadIdx.x == 0) {
        unsigned* bar = b.bar;
        __builtin_amdgcn_s_waitcnt(0);
        unsigned nloc = b.st[0], nx = b.st[1];
        if (nloc == 0u) { xcd_barrier_complete(bar, b.x, nloc, nx); b.st[0] = nloc; b.st[1] = nx; }
        const unsigned old = xb_add(&bar[XB_XSUB(b.x)], 1u);
        const unsigned gen = old / nloc;
        if (old + 1u == (gen + 1u) * nloc) {
            __builtin_amdgcn_fence(__ATOMIC_RELEASE, "agent");
            asm volatile("s_waitcnt vmcnt(0)" ::: "memory");
            const unsigned og = xb_add(&bar[XB_TOP], 1u);
            const unsigned tg = og / nx;
            if (og + 1u == (tg + 1u) * nx) xb_add(&bar[XB_TOPGEN], 1u);
            else XB_SPIN(xb_ld(&bar[XB_TOPGEN]) == tg, bar);
            __builtin_amdgcn_fence(__ATOMIC_ACQUIRE, "agent");
            xb_add(&bar[XB_XGEN(b.x)], 1u);
            asm volatile("s_waitcnt vmcnt(0)" ::: "memory");
        } else {
            XB_SPIN(xb_ld(&bar[XB_XGEN(b.x)]) == gen, bar);
            __builtin_amdgcn_fence(__ATOMIC_ACQUIRE, "agent");
            asm volatile("s_waitcnt vmcnt(0)" ::: "memory");
        }
    }
    __syncthreads();
}

template <int ST> __device__ __forceinline__ void run_from(unsigned char* lds, const XcdBarrier& bar, int lo, int hi) {
    if constexpr (ST < N_STAGES) {
        if (lo <= ST && ST < hi) {
            run_stage<ST>(lds);
            if (ST + 1 < hi) { if (ST == 0) cooperative_groups::this_grid().sync(); else xcd_barrier(bar); }
        }
        run_from<ST + 1>(lds, bar, lo, hi);
    }
}
constexpr int LDSCTL_OFF = 131072, MISC_OFF = LDSCTL_OFF + 320;
constexpr int CW_BAR = 4096;
struct KArgs { const void* p[N_IN + 2]; int st_lo, st_hi; };

__global__ void __launch_bounds__(512, 2) mk_fwd(KArgs ka) {
    extern __shared__ __attribute__((aligned(16))) unsigned char lds[];
    namespace cg = cooperative_groups;
    const bool multi = (ka.st_hi - ka.st_lo) > 1;
    XcdBarrier bar; bar.bar = nullptr; bar.x = 0; bar.st = nullptr;
    if (multi) {
        for (int u = threadIdx.x; u < (LDS_BYTES - LDSCTL_OFF) / 4; u += 512) ((LAS unsigned*)((LAS unsigned char*)lds + LDSCTL_OFF))[u] = 0u;
        __syncthreads();
        unsigned* ctl = (unsigned*)((unsigned char*)ka.p[N_IN + 1] + WS_CTL);
        bar = xcd_barrier_post(ctl + CW_BAR, (volatile LAS unsigned*)((LAS unsigned char*)lds + MISC_OFF) + 8);
    }
    run_from<0>(lds, bar, ka.st_lo, ka.st_hi);
}

extern "C" void kernel_launch(void* const* d_in, const int* in_sizes, int n_in, void* d_out, int out_size, void* d_ws, size_t ws_size, hipStream_t stream) {
    static int grid = 0;
    if (grid == 0) {
        if (n_in != N_IN || out_size != MROWS * DM || ws_size < WS_END) { fprintf(stderr, "kernel_launch: unexpected shapes (n_in %d, out %d, ws %zu)\n", n_in, out_size, ws_size); grid = -1; return; }
        int dev = 0, cus = 0, per_cu = 0;
        if (hipGetDevice(&dev) != hipSuccess || hipDeviceGetAttribute(&cus, hipDeviceAttributeMultiprocessorCount, dev) != hipSuccess) { grid = -1; return; }
        if (hipFuncSetAttribute((const void*)mk_fwd, hipFuncAttributeMaxDynamicSharedMemorySize, LDS_BYTES) != hipSuccess) { fprintf(stderr, "kernel_launch: hipFuncSetAttribute failed\n"); grid = -1; return; }
        if (hipOccupancyMaxActiveBlocksPerMultiprocessor(&per_cu, (const void*)mk_fwd, 512, LDS_BYTES) != hipSuccess || per_cu < 1) { fprintf(stderr, "kernel_launch: occupancy query says %d blocks per CU\n", per_cu); (void)hipGetLastError(); grid = -1; return; }
        grid = cus;
    }
    if (grid < 0) return;
    (void)hipMemsetAsync((char*)d_ws + WS_CTL, 0, CTL_BYTES, stream);
    KArgs a{};
    for (int i = 0; i < N_IN; ++i) a.p[i] = d_in[i];
    a.p[N_IN] = d_out; a.p[N_IN + 1] = d_ws; a.st_lo = 0; a.st_hi = N_STAGES;
    void* args[] = {&a};
    hipError_t e = hipLaunchCooperativeKernel((const void*)mk_fwd, dim3(grid), dim3(512), args, LDS_BYTES, stream);
    if (e != hipSuccess) fprintf(stderr, "kernel_launch: cooperative launch failed: %s (grid %d)\n", hipGetErrorString(e), grid);
}
```

```cpp
#include <hip/hip_runtime.h>
#include <hip/hip_cooperative_groups.h>
#include <cstdint>
#include <cstdio>

#define LAS __attribute__((address_space(3)))
typedef unsigned short bf16_t;
typedef short bf16x8 __attribute__((ext_vector_type(8)));
typedef float f32x4 __attribute__((ext_vector_type(4)));
typedef unsigned u32x4 __attribute__((ext_vector_type(4)));
typedef unsigned u32x2 __attribute__((ext_vector_type(2)));

constexpr int NB = 8, SEQ = 2048, NMETA = 16, LPAD = 2112, DM = 1024, MROWS = NB * SEQ;
constexpr int DFF = 2816, DIN = 5792, NGU = 2 * DFF;
constexpr int PA_N = 2816;
constexpr int OFF_CKV = 384, OFF_KR = 640, OFF_XBAR = 672, OFF_BG = 1184, OFF_CG = 1696, OFF_U = 2208, OFF_GATES = 2720;
constexpr int NSS = 20;
constexpr float ALPHA = 1.41421356237309515f;
constexpr float LN_EPS = 1e-5f, RMS_EPS = 1e-6f;
constexpr float QSCALE = 0.10206207261596577f * 1.4426950408889634f;

enum { I_X = 0, I_META, I_F1G, I_F1U, I_F1D, I_LN1G, I_LN1B, I_WIN, I_QNG, I_WUQ, I_KVNG, I_WUKV, I_WOA, I_CONVW, I_CONVB, I_WOB,
       I_SARE, I_SAIM, I_SLDT, I_SBRE, I_SBIM, I_SCRE, I_SCIM, I_SD, I_WGLU, I_BGLU, I_WOC, I_WO, I_LN2G, I_LN2B, I_F2G, I_F2U, I_F2D, I_LN3G, I_LN3B, N_IN };

constexpr size_t MiB = 1u << 20;
constexpr size_t WS_CTL = 0, CTL_BYTES = 1 * MiB;
constexpr size_t WS_TAB = 1 * MiB;
constexpr size_t TAB_COS = 0, TAB_SIN = 132096, TAB_AB = 264192, TAB_BBR = 296960, TAB_BBI = 559104;
constexpr size_t WS_META = 2 * MiB;
constexpr size_t MT_X = 0, MT_XN = 65536, MT_H = 98304, MT_PROJ = 188416, MT_Q = 278528, MT_GB = 303104, MT_YC = 319488, MT_YG = 335872, MT_SG = 352256, MT_MIX = 450560, MT_SS = 483328;
constexpr size_t WS_SS = 4 * MiB;
constexpr size_t WS_SLOT0 = 6 * MiB, WS_SLOT1 = 18 * MiB;
constexpr size_t WS_XN = 30 * MiB;
constexpr size_t WS_R1 = 62 * MiB;
constexpr size_t WS_Q = 158 * MiB;
constexpr size_t WS_KV = 182 * MiB;
constexpr size_t WS_KR = 215 * MiB;
constexpr size_t WS_GB = 217 * MiB, WS_YC = 233 * MiB, WS_YG = 249 * MiB, WS_END = 265 * MiB;

constexpr int LDS_BYTES = 147456;

#define CAS __attribute__((address_space(4)))
struct Args { const void* CAS const* kp; int opq;
    __device__ __forceinline__ const float* in(int i) const { return (const float*)kp[i + opq]; }
    __device__ __forceinline__ float* out() const { return (float*)kp[N_IN + opq]; }
    __device__ __forceinline__ unsigned char* ws() const { return (unsigned char*)kp[N_IN + 1 + opq]; } };

__device__ __forceinline__ unsigned f2bf(float f) { unsigned u = __float_as_uint(f); return (u + 0x7fffu + ((u >> 16) & 1u)) >> 16; }
__device__ __forceinline__ unsigned pk2(float lo, float hi) { return f2bf(lo) | (f2bf(hi) << 16); }
__device__ __forceinline__ float bflo(unsigned w) { return __uint_as_float(w << 16); }
__device__ __forceinline__ float bfhi(unsigned w) { return __uint_as_float(w & 0xffff0000u); }
__device__ __forceinline__ float bf2f(bf16_t h) { return __uint_as_float((unsigned)h << 16); }
__device__ __forceinline__ float sigmoidf_(float x) { return 1.0f / (1.0f + __expf(-x)); }
__device__ __forceinline__ float gelu_tanh(float x) { const float z = 0.7978845608028654f * (x + 0.044715f * x * x * x); const float e = __expf(2.0f * z); const float t = 1.0f - 2.0f / (e + 1.0f); return 0.5f * x * (1.0f + t); }
__device__ __forceinline__ float wave_sum(float v) {
#pragma unroll
    for (int o = 1; o < 64; o <<= 1) v += __shfl_xor(v, o);
    return v;
}
__device__ __forceinline__ float wave_max(float v) {
#pragma unroll
    for (int o = 1; o < 64; o <<= 1) v = fmaxf(v, __shfl_xor(v, o));
    return v;
}
__device__ __forceinline__ u32x2 pack4(f32x4 v) { u32x2 w; w.x = pk2(v[0], v[1]); w.y = pk2(v[2], v[3]); return w; }
__device__ __forceinline__ f32x4 unpack4(u32x2 w) { return (f32x4){bflo(w.x), bfhi(w.x), bflo(w.y), bfhi(w.y)}; }

struct EpiSwiglu { bf16_t* H; int ldh;
    __device__ __forceinline__ void pair(int row, int c0, f32x4 g, f32x4 u) const {
        const int hc = (c0 >> 5) * 16 + (c0 & 31); f32x4 h;
#pragma unroll
        for (int i = 0; i < 4; ++i) h[i] = g[i] * sigmoidf_(g[i]) * u[i];
        *(u32x2*)(H + (size_t)row * ldh + hc) = pack4(h); } };
struct EpiResid { const float* Xin; float* Xout; float alpha, s;
    __device__ __forceinline__ void pair(int row, int c0, f32x4 v0, f32x4 v1) const {
        const size_t o = (size_t)row * DM + c0; const f32x4 a = *(const f32x4*)(Xin + o), b = *(const f32x4*)(Xin + o + 16);
        *(f32x4*)(Xout + o) = a * alpha + v0 * s; *(f32x4*)(Xout + o + 16) = b * alpha + v1 * s; } };
struct EpiProjA { bf16_t* P; float* SS;
    __device__ __forceinline__ void pair(int row, int c0, f32x4 v0, f32x4 v1) const {
        const u32x2 w0 = pack4(v0), w1 = pack4(v1);
        *(u32x2*)(P + (size_t)row * PA_N + c0) = w0; *(u32x2*)(P + (size_t)row * PA_N + c0 + 16) = w1;
        if ((c0 >> 5) < NSS) { const f32x4 a = unpack4(w0), b = unpack4(w1);
            float ss = (a[0] * a[0] + a[1] * a[1]) + (a[2] * a[2] + a[3] * a[3]) + (b[0] * b[0] + b[1] * b[1]) + (b[2] * b[2] + b[3] * b[3]);
            ss += __shfl_xor(ss, 16); ss += __shfl_xor(ss, 32);
            if ((threadIdx.x & 63) < 16) SS[(size_t)row * NSS + (c0 >> 5)] = ss; } } };
struct EpiUq { bf16_t* Q; const float* SS; const float* rcos; const float* rsin; int posoff, posmask;
    __device__ __forceinline__ void pair(int row, int c0, f32x4 v0, f32x4 v1) const {
        const f32x4 s0 = *(const f32x4*)(SS + (size_t)row * NSS), s1 = *(const f32x4*)(SS + (size_t)row * NSS + 4), s2 = *(const f32x4*)(SS + (size_t)row * NSS + 8);
        const float ss = ((s0[0] + s0[1]) + (s0[2] + s0[3])) + ((s1[0] + s1[1]) + (s1[2] + s1[3])) + ((s2[0] + s2[1]) + (s2[2] + s2[3]));
        const float sc = rsqrtf(ss * (1.0f / 384.0f) + RMS_EPS) * QSCALE;
        v0 = v0 * sc; v1 = v1 * sc;
        if (c0 >= 512) { const int j = (c0 - 512) & 31; const int pos = posoff + (row & posmask);
            const f32x4 cs = *(const f32x4*)(rcos + pos * 16 + j), sn = *(const f32x4*)(rsin + pos * 16 + j);
            const f32x4 a = v0 * cs - v1 * sn, b = v1 * cs + v0 * sn; v0 = a; v1 = b; }
        *(u32x2*)(Q + (size_t)row * 768 + c0) = pack4(v0); *(u32x2*)(Q + (size_t)row * 768 + c0 + 16) = pack4(v1); } };
struct EpiUkv { bf16_t* KV; const float* SS; int meta;
    __device__ __forceinline__ void pair(int row, int c0, f32x4 v0, f32x4 v1) const {
        const f32x4 s0 = *(const f32x4*)(SS + (size_t)row * NSS + 12), s1 = *(const f32x4*)(SS + (size_t)row * NSS + 16);
        const float ss = ((s0[0] + s0[1]) + (s0[2] + s0[3])) + ((s1[0] + s1[1]) + (s1[2] + s1[3]));
        const float sc = rsqrtf(ss * (1.0f / 256.0f) + RMS_EPS);
        const u32x2 w0 = pack4(v0 * sc), w1 = pack4(v1 * sc);
        if (!meta) { const size_t dr = (size_t)row + 64 * (row >> 11) + 16; *(u32x2*)(KV + dr * 1024 + c0) = w0; *(u32x2*)(KV + dr * 1024 + c0 + 16) = w1; }
        else { for (int b = 0; b < NB; ++b) { const size_t dr = (size_t)b * LPAD + row; *(u32x2*)(KV + dr * 1024 + c0) = w0; *(u32x2*)(KV + dr * 1024 + c0 + 16) = w1; } } } };
struct EpiSig { bf16_t* SG;
    __device__ __forceinline__ void pair(int row, int c0, f32x4 v0, f32x4 v1) const {
        f32x4 a, b;
#pragma unroll
        for (int i = 0; i < 4; ++i) { a[i] = sigmoidf_(v0[i]); b[i] = sigmoidf_(v1[i]); }
        *(u32x2*)(SG + (size_t)row * 3072 + c0) = pack4(a); *(u32x2*)(SG + (size_t)row * 3072 + c0 + 16) = pack4(b); } };
struct EpiGlu { bf16_t* YG; const bf16_t* YC; const float* bglu;
    __device__ __forceinline__ void pair(int row, int c0, f32x4 v0, f32x4 v1) const {
        const f32x4 y0 = unpack4(*(const u32x2*)(YC + (size_t)row * 512 + c0)), y1 = unpack4(*(const u32x2*)(YC + (size_t)row * 512 + c0 + 16));
        const f32x4 b0 = *(const f32x4*)(bglu + c0), b1 = *(const f32x4*)(bglu + c0 + 16); f32x4 a, b;
#pragma unroll
        for (int i = 0; i < 4; ++i) { a[i] = y0[i] * sigmoidf_(v0[i] + b0[i]); b[i] = y1[i] * sigmoidf_(v1[i] + b1[i]); }
        *(u32x2*)(YG + (size_t)row * 512 + c0) = pack4(a); *(u32x2*)(YG + (size_t)row * 512 + c0 + 16) = pack4(b); } };
struct EpiMerge { bf16_t* MX; const bf16_t* SG; int gi; int first;
    __device__ __forceinline__ void pair(int row, int c0, f32x4 v0, f32x4 v1) const {
        const bf16_t* sg = SG + (size_t)row * 3072 + gi * 1024 + c0; bf16_t* mx = MX + (size_t)row * DM + c0;
        f32x4 a = unpack4(*(const u32x2*)sg) * v0, b = unpack4(*(const u32x2*)(sg + 16)) * v1;
        if (!first) { a = a + unpack4(*(const u32x2*)mx); b = b + unpack4(*(const u32x2*)(mx + 16)); }
        *(u32x2*)mx = pack4(a); *(u32x2*)(mx + 16) = pack4(b); } };

template <class Epi>
__device__ __forceinline__ void gemm_simple(const bf16_t* A, int lda, const bf16_t* Bt, int K, int Mr, int Nc, const Epi& E) {
    const int lane = threadIdx.x & 63, wid = threadIdx.x >> 6, fr = lane & 15, fq = lane >> 4;
    const int gw = blockIdx.x * 8 + wid, NGW = gridDim.x * 8, nct = Nc / 64, nit = (Mr / 32) * nct;
    for (int it = gw; it < nit; it += NGW) {
        const int rt = it / nct, ct = it % nct;
        f32x4 acc[2][4];
#pragma unroll
        for (int m = 0; m < 2; ++m)
#pragma unroll
            for (int n = 0; n < 4; ++n) acc[m][n] = (f32x4){0.f, 0.f, 0.f, 0.f};
        const bf16_t* ap = A + (size_t)(rt * 32 + fr) * lda + 8 * fq;
        const bf16_t* bp = Bt + (size_t)(ct * 64 + fr) * K + 8 * fq;
        for (int k0 = 0; k0 < K; k0 += 32) {
            bf16x8 a[2], b[4];
#pragma unroll
            for (int m = 0; m < 2; ++m) a[m] = *(const bf16x8*)(ap + (size_t)m * 16 * lda + k0);
#pragma unroll
            for (int n = 0; n < 4; ++n) b[n] = *(const bf16x8*)(bp + (size_t)n * 16 * K + k0);
#pragma unroll
            for (int m = 0; m < 2; ++m)
#pragma unroll
                for (int n = 0; n < 4; ++n) acc[m][n] = __builtin_amdgcn_mfma_f32_16x16x32_bf16(b[n], a[m], acc[m][n], 0, 0, 0);
        }
#pragma unroll
        for (int m = 0; m < 2; ++m)
#pragma unroll
            for (int np = 0; np < 2; ++np) E.pair(rt * 32 + m * 16 + fr, ct * 64 + np * 32 + 4 * fq, acc[m][2 * np], acc[m][2 * np + 1]);
    }
}
template <class Epi>
__device__ __forceinline__ void gemm_meta(const bf16_t* A, int lda, const bf16_t* Bt, int K, int Nc, const Epi& E, float* red) {
    const int lane = threadIdx.x & 63, wid = threadIdx.x >> 6, fr = lane & 15, fq = lane >> 4;
    __syncthreads();
    for (int cg = (int)blockIdx.x; cg < Nc / 32; cg += (int)gridDim.x) {
        f32x4 a0 = (f32x4){0.f, 0.f, 0.f, 0.f}, a1 = a0;
        const bf16_t* ap = A + (size_t)fr * lda + 8 * fq;
        const bf16_t* bp = Bt + (size_t)(cg * 32 + fr) * K + 8 * fq;
        for (int ks = wid; ks < K / 32; ks += 8) {
            const bf16x8 a = *(const bf16x8*)(ap + ks * 32);
            const bf16x8 b0 = *(const bf16x8*)(bp + ks * 32), b1 = *(const bf16x8*)(bp + (size_t)16 * K + ks * 32);
            a0 = __builtin_amdgcn_mfma_f32_16x16x32_bf16(b0, a, a0, 0, 0, 0);
            a1 = __builtin_amdgcn_mfma_f32_16x16x32_bf16(b1, a, a1, 0, 0, 0);
        }
        *(f32x4*)(red + (wid * 64 + lane) * 8) = a0; *(f32x4*)(red + (wid * 64 + lane) * 8 + 4) = a1;
        __syncthreads();
        if (wid == 0) {
            f32x4 s0 = (f32x4){0.f, 0.f, 0.f, 0.f}, s1 = s0;
#pragma unroll
            for (int w = 0; w < 8; ++w) { s0 = s0 + *(const f32x4*)(red + (w * 64 + lane) * 8); s1 = s1 + *(const f32x4*)(red + (w * 64 + lane) * 8 + 4); }
            E.pair(fr, cg * 32 + 4 * fq, s0, s1);
        }
        __syncthreads();
    }
}

namespace pg8 {
#define PG8_LAS __attribute__((address_space(3)))
typedef unsigned short bf16_t;
typedef short bf16x8 __attribute__((ext_vector_type(8)));
typedef float f32x4 __attribute__((ext_vector_type(4)));
typedef unsigned u32x4 __attribute__((ext_vector_type(4)));
constexpr int BM = 256, BK = 64, HALF = 128, HTB = HALF * BK * 2  , STAGE_BYTES = 8 * HTB, NXCD = 8, WGM = 8;

__host__ __device__ __forceinline__ int lds_byte(int r, int c) { const int st = (r >> 4) * 2 + (c >> 5), rr = r & 15, cc = c & 31, ob = rr * 64 + cc * 2; return st * 1024 + (ob ^ (((ob >> 9) & 1) << 5)); }
__host__ __device__ __forceinline__ void stage_rc(int b, int& R, int& C) { const int st = b / 1024, sb = b % 1024, swz = sb ^ (((sb >> 9) & 1) << 5); R = (st >> 1) * 16 + swz / 64; C = (st & 1) * 32 + (swz % 64) / 2; }
__host__ __device__ __forceinline__ int perm32(int rho) { const int n = rho >> 4, i = rho & 15; return 8 * (i >> 2) + 4 * n + (i & 3); }

struct Unit { int pm, pn; };
struct Gemm { const bf16_t* A; const bf16_t* Bt; int M, N, K, lda; };

struct StaticOrder {
    int nM, nN, nwg, G, c;
    __host__ __device__ void init(int M, int N, int G_, int c_) { nM = M / BM; nN = N / BM; nwg = nM * nN; G = G_; c = c_; }
    __host__ __device__ bool next(int i, Unit& u) const {
        const long L = (long)i * G + c; if (L >= nwg) return false;
        int wgid = (int)L; { const int q = nwg / NXCD, r = nwg % NXCD, xcd = wgid % NXCD, off = wgid / NXCD; wgid = (xcd < r ? xcd * (q + 1) : r * (q + 1) + (xcd - r) * q) + off; }
        const int nig = WGM * nN, gid = wgid / nig, fm = gid * WGM, gsz = (nM - fm) < WGM ? (nM - fm) : WGM;
        u.pm = fm + ((wgid % nig) % gsz); u.pn = (wgid % nig) / gsz; return true;
    }
    __device__ __forceinline__ void a_ready(const Unit&) const {}
    __device__ __forceinline__ void done(const Unit&) const {}
};


template <class F> struct EpiPair {
    static constexpr bool PERM = false, AFTER_DRAIN = false; F f;
    __device__ __forceinline__ void operator()(const f32x4 (&acc)[2][2][4][2], const Unit& u, int wr, int wc, int fr, int fq) const {
#pragma unroll
        for (int ai = 0; ai < 2; ++ai)
#pragma unroll
            for (int m = 0; m < 4; ++m) {
#pragma unroll
                for (int bj = 0; bj < 2; ++bj) f.pair(u.pm * BM + ai * HALF + wr * 64 + m * 16 + fr, u.pn * BM + bj * HALF + wc * 32 + 4 * fq, acc[ai][bj][m][0], acc[ai][bj][m][1]);
                asm volatile("" ::: "memory"); }
    }
};
template <class Epi, class Sched, bool ALIGN_EPI = false, bool SP2 = false>
__device__ __forceinline__ void gemm_phase(PG8_LAS unsigned char* lds, const Gemm g, const Sched& S, const Epi& E) {
    const int tid = threadIdx.x, wid = __builtin_amdgcn_readfirstlane(tid >> 6), lane = tid & 63, wr = wid >> 2, wc = wid & 3, fr = lane & 15, fq = lane >> 4;
    const int K = g.K, nt = K / BK;
    unsigned voffA[2], voffB[2];
#pragma unroll
    for (int i = 0; i < 2; ++i) { int R, C; stage_rc(tid * 16 + i * 8192, R, C); const int Rb = Epi::PERM ? ((R & ~31) + perm32(R & 31)) : R;
        voffA[i] = (unsigned)(R * g.lda + C) * 2u; voffB[i] = (unsigned)(Rb * K + C) * 2u; }
    const size_t kstep = (size_t)(BK * 2);
    const size_t hstepA = (size_t)HALF * g.lda * 2, hstepB = (size_t)HALF * K * 2;
    const size_t tstepA = 2 * hstepA, tstepB = 2 * hstepB;
    const unsigned ldsw = (unsigned)wid * 1024u;
    const int aoff = lds_byte(wr * 64 + fr, fq * 8), boff = lds_byte(wc * 32 + fr, fq * 8);
#define PG8_SA(b, h) (((b) * 2 + (h)) * HTB)
#define PG8_SB(b, h) ((4 + (b) * 2 + (h)) * HTB)
#define PG8_STAGE(bufoff, gbase, voff) do { _Pragma("unroll") for (int _i = 0; _i < 2; ++_i) \
        __builtin_amdgcn_global_load_lds((const unsigned*)((const char*)(gbase) + (voff)[_i]), (PG8_LAS unsigned*)(lds + (bufoff) + ldsw + _i * 8192), 16, 0, 0); } while (0)
#define PG8_LDA(dst, b, h) do { _Pragma("unroll") for (int m = 0; m < 4; ++m) _Pragma("unroll") for (int k = 0; k < 2; ++k) dst[m][k] = *(const PG8_LAS bf16x8*)(lds + PG8_SA(b, h) + aoff + m * 2048 + k * 1024); } while (0)
#define PG8_LDB(dst, b, h) do { _Pragma("unroll") for (int n = 0; n < 2; ++n) _Pragma("unroll") for (int k = 0; k < 2; ++k) dst[n][k] = *(const PG8_LAS bf16x8*)(lds + PG8_SB(b, h) + boff + n * 2048 + k * 1024); } while (0)
#define PG8_MMA(ai, bj, At, Bt) do { __builtin_amdgcn_s_setprio(1); _Pragma("unroll") for (int m = 0; m < 4; ++m) _Pragma("unroll") for (int n = 0; n < 2; ++n) _Pragma("unroll") for (int k = 0; k < 2; ++k) \
        acc[ai][bj][m][n] = __builtin_amdgcn_mfma_f32_16x16x32_bf16(Bt[n][k], At[m][k], acc[ai][bj][m][n], 0, 0, 0); __builtin_amdgcn_s_setprio(0); } while (0)
#define PG8_WAIT_V(n) asm volatile("s_waitcnt vmcnt(" #n ")" ::: "memory")
#define PG8_WAIT_L(n) asm volatile("s_waitcnt lgkmcnt(" #n ")" ::: "memory")
#define PG8_BAR __builtin_amdgcn_s_barrier()
#define PG8_SCHED __builtin_amdgcn_sched_barrier(0)
    Unit cur, nxt; int ui = 0;
    if (!S.next(0, cur)) return;
    f32x4 acc[2][2][4][2];
#pragma unroll
    for (int a = 0; a < 2; ++a)
#pragma unroll
        for (int b = 0; b < 2; ++b)
#pragma unroll
            for (int m = 0; m < 4; ++m)
#pragma unroll
                for (int n = 0; n < 2; ++n) acc[a][b][m][n] = (f32x4){0.f, 0.f, 0.f, 0.f};
    bf16x8 At[4][2], B0[2][2], B1[2][2];
    const char* cA = (const char*)g.A + (size_t)cur.pm * tstepA; const char* cB = (const char*)g.Bt + (size_t)cur.pn * tstepB;
    S.a_ready(cur);
    if constexpr (SP2) {
        PG8_STAGE(PG8_SB(0, 0), cB, voffB); PG8_STAGE(PG8_SB(0, 1), cB + hstepB, voffB); PG8_STAGE(PG8_SA(0, 0), cA, voffA); PG8_STAGE(PG8_SA(0, 1), cA + hstepA, voffA);
        if (wr == 1) PG8_BAR;
        PG8_WAIT_V(2); PG8_BAR;
        PG8_STAGE(PG8_SB(1, 0), cB + kstep, voffB); PG8_STAGE(PG8_SA(1, 0), cA + kstep, voffA); PG8_STAGE(PG8_SB(1, 1), cB + hstepB + kstep, voffB);
        PG8_WAIT_V(6); PG8_BAR;
    } else {
        PG8_STAGE(PG8_SB(0, 0), cB, voffB); PG8_STAGE(PG8_SA(0, 0), cA, voffA); PG8_STAGE(PG8_SB(0, 1), cB + hstepB, voffB); PG8_STAGE(PG8_SA(0, 1), cA + hstepA, voffA);
        if (wr == 1) PG8_BAR;
        PG8_WAIT_V(4); PG8_BAR;
        PG8_STAGE(PG8_SB(1, 0), cB + kstep, voffB); PG8_STAGE(PG8_SA(1, 0), cA + kstep, voffA); PG8_STAGE(PG8_SB(1, 1), cB + hstepB + kstep, voffB);
        PG8_WAIT_V(6); PG8_BAR;
    }
    for (;;) {
        const bool has_next = S.next(ui + 1, nxt);
        const char* nA = has_next ? (const char*)g.A + (size_t)nxt.pm * tstepA : cA; const char* nB = has_next ? (const char*)g.Bt + (size_t)nxt.pn * tstepB : cB;
#pragma nounroll
        for (int t = 0; t < nt; t += 2) {
            const bool last = (t == nt - 2);
            const char* a1 = cA + (size_t)(t + 1) * kstep;
            const char* a2 = last ? nA : cA + (size_t)(t + 2) * kstep; const char* b2 = last ? nB : cB + (size_t)(t + 2) * kstep;
            const char* a3 = a2 + kstep; const char* b3 = b2 + kstep;
            if (last && has_next) S.a_ready(nxt);
            if constexpr (SP2) {
            PG8_LDB(B0, 0, 0); PG8_LDB(B1, 0, 1); PG8_SCHED; PG8_LDA(At, 0, 0); PG8_STAGE(PG8_SA(1, 1), a1 + hstepA, voffA);
            PG8_WAIT_V(8); PG8_WAIT_L(0); PG8_BAR; PG8_MMA(0, 0, At, B0); PG8_MMA(0, 1, At, B1); PG8_BAR; PG8_SCHED;
            PG8_LDA(At, 0, 1); PG8_STAGE(PG8_SB(0, 0), b2, voffB); PG8_STAGE(PG8_SB(0, 1), b2 + hstepB, voffB); PG8_STAGE(PG8_SA(0, 0), a2, voffA);
            PG8_WAIT_V(8); PG8_WAIT_L(0); PG8_BAR; PG8_MMA(1, 0, At, B0); PG8_MMA(1, 1, At, B1); PG8_BAR; PG8_SCHED;
            PG8_LDB(B0, 1, 0); PG8_LDB(B1, 1, 1); PG8_SCHED; PG8_LDA(At, 1, 0); PG8_STAGE(PG8_SA(0, 1), a2 + hstepA, voffA);
            PG8_WAIT_V(8); PG8_WAIT_L(0); PG8_BAR; PG8_MMA(0, 0, At, B0); PG8_MMA(0, 1, At, B1); PG8_BAR; PG8_SCHED;
            PG8_LDA(At, 1, 1); PG8_STAGE(PG8_SB(1, 0), b3, voffB); PG8_STAGE(PG8_SB(1, 1), b3 + hstepB, voffB); PG8_STAGE(PG8_SA(1, 0), a3, voffA);
            PG8_WAIT_V(8); PG8_WAIT_L(0); PG8_BAR; PG8_MMA(1, 0, At, B0); PG8_MMA(1, 1, At, B1); PG8_BAR; PG8_SCHED;
            } else {
            PG8_LDB(B0, 0, 0); PG8_SCHED; PG8_LDA(At, 0, 0); PG8_STAGE(PG8_SA(1, 1), a1 + hstepA, voffA);
            PG8_WAIT_L(8); PG8_BAR; PG8_WAIT_L(0); PG8_MMA(0, 0, At, B0); PG8_BAR; PG8_SCHED;
            PG8_LDB(B1, 0, 1); PG8_STAGE(PG8_SB(0, 0), b2, voffB);
            PG8_BAR; PG8_WAIT_L(0); PG8_MMA(0, 1, At, B1); PG8_BAR;
            PG8_LDA(At, 0, 1); PG8_STAGE(PG8_SA(0, 0), a2, voffA);
            PG8_BAR; PG8_WAIT_L(0); PG8_MMA(1, 0, At, B0); PG8_BAR; PG8_SCHED;
            PG8_STAGE(PG8_SB(0, 1), b2 + hstepB, voffB);
            PG8_WAIT_V(6); PG8_BAR; PG8_MMA(1, 1, At, B1); PG8_BAR;
            PG8_LDB(B0, 1, 0); PG8_SCHED; PG8_LDA(At, 1, 0); PG8_STAGE(PG8_SA(0, 1), a2 + hstepA, voffA);
            PG8_WAIT_L(8); PG8_BAR; PG8_WAIT_L(0); PG8_MMA(0, 0, At, B0); PG8_BAR; PG8_SCHED;
            PG8_LDB(B1, 1, 1); PG8_STAGE(PG8_SB(1, 0), b3, voffB);
            PG8_BAR; PG8_WAIT_L(0); PG8_MMA(0, 1, At, B1); PG8_BAR;
            PG8_LDA(At, 1, 1); PG8_STAGE(PG8_SA(1, 0), a3, voffA);
            PG8_BAR; PG8_WAIT_L(0); PG8_MMA(1, 0, At, B0); PG8_BAR; PG8_SCHED;
            PG8_STAGE(PG8_SB(1, 1), b3 + hstepB, voffB);
            PG8_WAIT_V(6); PG8_BAR; PG8_MMA(1, 1, At, B1); PG8_BAR;
            }
        }
        if constexpr (ALIGN_EPI) { if (wr == 0) PG8_BAR; }
        if constexpr (!Epi::AFTER_DRAIN) { E(acc, cur, wr, wc, fr, fq); S.done(cur); }
        if (!has_next) break;
#pragma unroll
        for (int a = 0; a < 2; ++a)
#pragma unroll
            for (int b = 0; b < 2; ++b)
#pragma unroll
                for (int m = 0; m < 4; ++m)
#pragma unroll
                    for (int n = 0; n < 2; ++n) acc[a][b][m][n] = (f32x4){0.f, 0.f, 0.f, 0.f};
        cur = nxt; cA = nA; cB = nB; ++ui;
        if constexpr (ALIGN_EPI) { if (wr == 1) PG8_BAR; }
    }
    PG8_WAIT_V(0);
    if constexpr (!ALIGN_EPI) { if (wr == 0) PG8_BAR; }
    PG8_BAR;
    if constexpr (Epi::AFTER_DRAIN) { E.fused(acc, cur, wr, wc, fr, fq, lds, wid, lane); S.done(cur); }
#undef PG8_SA
#undef PG8_SB
#undef PG8_STAGE
#undef PG8_LDA
#undef PG8_LDB
#undef PG8_MMA
#undef PG8_WAIT_V
#undef PG8_WAIT_L
#undef PG8_BAR
#undef PG8_SCHED
}
}

template <class F> __device__ __forceinline__ void gemm_eng(unsigned char* lds, const bf16_t* A, int lda, const bf16_t* Bt, int K, int N, const F& f) {
    __syncthreads();
    pg8::Gemm g{A, Bt, MROWS, N, K, lda}; pg8::StaticOrder S; S.init(MROWS, N, (int)gridDim.x, (int)blockIdx.x);
    pg8::EpiPair<F> E{f};
    pg8::gemm_phase<pg8::EpiPair<F>, pg8::StaticOrder, true, true>((LAS unsigned char*)lds, g, S, E);
}

struct WDesc { const float* src0; const float* src1; int srcN; int K; bf16_t* dst; int rows; int kind; int coff; int nvalid; const float* scale; };
__device__ __forceinline__ void cvt_weight(const WDesc& d, float* scr_all) {
    const int lane = threadIdx.x & 63, wid = threadIdx.x >> 6;
    float* scr = scr_all + wid * (64 * 33);
    const int gw = blockIdx.x * 8 + wid, NGW = gridDim.x * 8, nblk = d.rows / 32, nit = (d.K / 64) * nblk;
    for (int it = gw; it < nit; it += NGW) {
        const int kb = it / nblk, nb = it % nblk, k0 = 64 * kb, n0 = 32 * nb;
        const int r = n0 + (lane & 31);
        const float* src = d.src0; int col = 0; bool valid = true;
        if (d.kind == 0) { valid = r < d.nvalid; col = d.coff + r; }
        else if (d.kind == 1) { const int q = r >> 5, w = r & 31; src = (w < 16) ? d.src0 : d.src1; col = 16 * q + (w & 15); }
        else { if (r < 512) col = (r >> 6) * 96 + (r & 63); else col = ((r - 512) >> 5) * 96 + 64 + ((r - 512) & 31); }
#pragma unroll 8
        for (int i = 0; i < 32; ++i) { const int kk = 2 * i + (lane >> 5);
            float v = valid ? src[(size_t)(k0 + kk) * d.srcN + col] : 0.f; if (d.scale) v *= d.scale[k0 + kk];
            scr[kk * 33 + (lane & 31)] = v; }
        const int c8 = lane & 7;
#pragma unroll
        for (int j = 0; j < 4; ++j) { const int n = (lane >> 3) + 8 * j; const float* s = scr + (8 * c8) * 33 + n;
            u32x4 o; o.x = pk2(s[0], s[33]); o.y = pk2(s[66], s[99]); o.z = pk2(s[132], s[165]); o.w = pk2(s[198], s[231]);
            *(u32x4*)(d.dst + (size_t)(n0 + n) * d.K + k0 + 8 * c8) = o; }
    }
}
__device__ __forceinline__ bf16_t* slot_ptr(const Args& a, int gp) { return (bf16_t*)(a.ws() + ((gp & 1) ? WS_SLOT1 : WS_SLOT0)); }
__device__ __forceinline__ void convert_phase(const Args& a, int l, int p, float* scr) {
    if (l > 1) return;
    __syncthreads();
    bf16_t* S = slot_ptr(a, 9 * l + p);
    WDesc d; d.src1 = nullptr; d.kind = 0; d.coff = 0; d.scale = nullptr;
    if (p == 1 || p == 8) {
        d.src0 = ((p == 1) ? a.in(I_F1G) : a.in(I_F2G)) + (size_t)l * DM * DFF; d.src1 = ((p == 1) ? a.in(I_F1U) : a.in(I_F2U)) + (size_t)l * DM * DFF; d.srcN = DFF; d.K = DM; d.dst = S; d.rows = NGU; d.kind = 1; d.nvalid = NGU; cvt_weight(d, scr); }
    else if (p == 2 || p == 9) {
        d.src0 = ((p == 2) ? a.in(I_F1D) : a.in(I_F2D)) + (size_t)l * DFF * DM; d.srcN = DM; d.K = DFF; d.dst = S; d.rows = DM; d.nvalid = DM; cvt_weight(d, scr); }
    else if (p == 3) { d.src0 = a.in(I_WIN) + (size_t)l * DM * DIN; d.srcN = DIN; d.K = DM; d.dst = S; d.rows = PA_N; d.nvalid = OFF_GATES; cvt_weight(d, scr); }
    else if (p == 4) {
        d.src0 = a.in(I_WUQ) + (size_t)l * 384 * 768; d.srcN = 768; d.K = 384; d.dst = S; d.rows = 768; d.kind = 2; d.nvalid = 768; d.scale = a.in(I_QNG) + l * 384; cvt_weight(d, scr);
        d.src0 = a.in(I_WUKV) + (size_t)l * 256 * 1024; d.srcN = 1024; d.K = 256; d.dst = S + (1 * MiB) / 2; d.rows = 1024; d.kind = 0; d.nvalid = 1024; d.scale = a.in(I_KVNG) + l * 256; cvt_weight(d, scr); }
    else if (p == 5) {
        d.src0 = a.in(I_WIN) + (size_t)l * DM * DIN; d.srcN = DIN; d.K = DM; d.dst = S; d.rows = 3072; d.coff = OFF_GATES; d.nvalid = 3072; cvt_weight(d, scr);
        d.src0 = a.in(I_WGLU) + (size_t)l * 512 * 512; d.srcN = 512; d.K = 512; d.dst = S + (8 * MiB) / 2; d.rows = 512; d.coff = 0; d.nvalid = 512; cvt_weight(d, scr); }
    else if (p == 6) {
        d.srcN = DM; d.K = 512; d.rows = DM; d.nvalid = DM;
        d.src0 = a.in(I_WOA) + (size_t)l * 512 * DM; d.dst = S; cvt_weight(d, scr);
        d.src0 = a.in(I_WOB) + (size_t)l * 512 * DM; d.dst = S + (1 * MiB) / 2; cvt_weight(d, scr);
        d.src0 = a.in(I_WOC) + (size_t)l * 512 * DM; d.dst = S + (2 * MiB) / 2; cvt_weight(d, scr); }
    else if (p == 7) { d.src0 = a.in(I_WO) + (size_t)l * DM * DM; d.srcN = DM; d.K = DM; d.dst = S; d.rows = DM; d.nvalid = DM; cvt_weight(d, scr); }
}
__device__ __forceinline__ void convert_next(const Args& a, int l, int p, float* scr) { if (p == 9) convert_phase(a, l + 1, 1, scr); else convert_phase(a, l, p + 1, scr); }

__device__ __forceinline__ void ln_row(float* xrow, bf16_t* orow, const float* g, const float* b, int lane) {
    f32x4 v[4]; float s = 0.f;
#pragma unroll
    for (int j = 0; j < 4; ++j) { v[j] = *(const f32x4*)(xrow + 4 * lane + 256 * j); s += (v[j][0] + v[j][1]) + (v[j][2] + v[j][3]); }
    const float mean = wave_sum(s) * (1.f / DM); float s2 = 0.f;
#pragma unroll
    for (int j = 0; j < 4; ++j) { v[j] = v[j] - mean; s2 += (v[j][0] * v[j][0] + v[j][1] * v[j][1]) + (v[j][2] * v[j][2] + v[j][3] * v[j][3]); }
    const float rstd = rsqrtf(wave_sum(s2) * (1.f / DM) + LN_EPS);
#pragma unroll
    for (int j = 0; j < 4; ++j) { const f32x4 gg = *(const f32x4*)(g + 4 * lane + 256 * j), bb = *(const f32x4*)(b + 4 * lane + 256 * j);
        const f32x4 o = v[j] * rstd * gg + bb; *(f32x4*)(xrow + 4 * lane + 256 * j) = o; *(u32x2*)(orow + 4 * lane + 256 * j) = pack4(o); }
}
__device__ __forceinline__ void stage_ln(const Args& a, const float* g, const float* b) {
    const int lane = threadIdx.x & 63, gw = blockIdx.x * 8 + (threadIdx.x >> 6), NGW = gridDim.x * 8;
    float* Xm = (float*)(a.ws() + WS_META + MT_X); bf16_t* XNm = (bf16_t*)(a.ws() + WS_META + MT_XN); bf16_t* XN = (bf16_t*)(a.ws() + WS_XN);
    for (int r = gw; r < MROWS + NMETA; r += NGW) {
        if (r < MROWS) ln_row(a.out() + (size_t)r * DM, XN + (size_t)r * DM, g, b, lane);
        else ln_row(Xm + (size_t)(r - MROWS) * DM, XNm + (size_t)(r - MROWS) * DM, g, b, lane);
    }
}
__device__ __forceinline__ void stage_prologue(const Args& a, float* scr) {
    const int tid = threadIdx.x, gt = blockIdx.x * 512 + tid, NGT = gridDim.x * 512;
    bf16_t* XN = (bf16_t*)(a.ws() + WS_XN); float* Xm = (float*)(a.ws() + WS_META + MT_X); bf16_t* XNm = (bf16_t*)(a.ws() + WS_META + MT_XN);
    const float* x = a.in(I_X);
    for (size_t i = gt; i < (size_t)MROWS * DM / 8; i += NGT) { const f32x4 p = *(const f32x4*)(x + i * 8), q = *(const f32x4*)(x + i * 8 + 4);
        u32x4 o; o.x = pk2(p[0], p[1]); o.y = pk2(p[2], p[3]); o.z = pk2(q[0], q[1]); o.w = pk2(q[2], q[3]); *(u32x4*)(XN + i * 8) = o; }
    for (int i = gt; i < NMETA * DM; i += NGT) { const float v = a.in(I_META)[i]; Xm[i] = v; XNm[i] = (bf16_t)f2bf(v); }
    float* rc = (float*)(a.ws() + WS_TAB + TAB_COS); float* rs = (float*)(a.ws() + WS_TAB + TAB_SIN);
    for (int i = gt; i < (SEQ + NMETA) * 16; i += NGT) { const int pos = i >> 4, j = i & 15; const double inv = pow(10000.0, -(double)j / 16.0), ang = (double)pos * inv; rc[i] = (float)cos(ang); rs[i] = (float)sin(ang); }
    float* AB = (float*)(a.ws() + WS_TAB + TAB_AB); float* BBR = (float*)(a.ws() + WS_TAB + TAB_BBR); float* BBI = (float*)(a.ws() + WS_TAB + TAB_BBI);
    for (int i = gt; i < 2 * 32 * 64; i += NGT) {
        const int lg = i >> 6; const double are = a.in(I_SARE)[i], aim = a.in(I_SAIM)[i], dt = exp((double)a.in(I_SLDT)[lg]);
        const double mag = exp(dt * are), abr = mag * cos(dt * aim), abi = mag * sin(dt * aim), den = are * are + aim * aim, nr = abr - 1.0, ni = abi;
        const double cr = (nr * are + ni * aim) / den, ci = (ni * are - nr * aim) / den;
        AB[2 * i] = (float)abr; AB[2 * i + 1] = (float)abi;
        for (int h = 0; h < 16; ++h) { const double br = a.in(I_SBRE)[(size_t)i * 16 + h], bi = a.in(I_SBIM)[(size_t)i * 16 + h];
            BBR[(size_t)i * 16 + h] = (float)(cr * br - ci * bi); BBI[(size_t)i * 16 + h] = (float)(cr * bi + ci * br); } }
    convert_phase(a, 0, 1, scr);
}
__device__ __forceinline__ void stage_krope_pad(const Args& a) {
    const int gt = blockIdx.x * 512 + threadIdx.x, NGT = gridDim.x * 512;
    const bf16_t* PA = (const bf16_t*)(a.ws() + WS_R1); const bf16_t* PM = (const bf16_t*)(a.ws() + WS_META + MT_PROJ);
    bf16_t* KR = (bf16_t*)(a.ws() + WS_KR); bf16_t* KV = (bf16_t*)(a.ws() + WS_KV);
    const float* rc = (const float*)(a.ws() + WS_TAB + TAB_COS); const float* rs = (const float*)(a.ws() + WS_TAB + TAB_SIN);
    for (int i = gt; i < (MROWS + NMETA) * 16; i += NGT) { const int r = i >> 4, j = i & 15;
        if (r < MROWS) { const int pos = 16 + (r & 2047); const bf16_t* p = PA + (size_t)r * PA_N + OFF_KR; const float x1 = bf2f(p[j]), x2 = bf2f(p[j + 16]), c = rc[pos * 16 + j], s = rs[pos * 16 + j];
            bf16_t* o = KR + ((size_t)r + 64 * (r >> 11) + 16) * 32; o[j] = (bf16_t)f2bf(x1 * c - x2 * s); o[j + 16] = (bf16_t)f2bf(x2 * c + x1 * s); }
        else { const int pos = r - MROWS; const bf16_t* p = PM + (size_t)pos * PA_N + OFF_KR; const float x1 = bf2f(p[j]), x2 = bf2f(p[j + 16]), c = rc[pos * 16 + j], s = rs[pos * 16 + j];
            const bf16_t o1 = (bf16_t)f2bf(x1 * c - x2 * s), o2 = (bf16_t)f2bf(x2 * c + x1 * s);
            for (int b = 0; b < NB; ++b) { bf16_t* o = KR + ((size_t)b * LPAD + pos) * 32; o[j] = o1; o[j + 16] = o2; } } }
    for (int i = gt; i < NB * 48 * 128; i += NGT) { const int b = i / (48 * 128), rem = i % (48 * 128), rr = rem >> 7, c = rem & 127; *(u32x4*)(KV + ((size_t)b * LPAD + 2064 + rr) * 1024 + c * 8) = (u32x4){0u, 0u, 0u, 0u}; }
    for (int i = gt; i < NB * 48 * 4; i += NGT) { const int b = i / (48 * 4), rem = i % (48 * 4), rr = rem >> 2, c = rem & 3; *(u32x4*)(KR + ((size_t)b * LPAD + 2064 + rr) * 32 + c * 8) = (u32x4){0u, 0u, 0u, 0u}; }
}
__device__ __forceinline__ void stage_conv(const Args& a, int l) {
    const int gt = blockIdx.x * 512 + threadIdx.x, NGT = gridDim.x * 512;
    const bf16_t* PA = (const bf16_t*)(a.ws() + WS_R1); const bf16_t* PM = (const bf16_t*)(a.ws() + WS_META + MT_PROJ);
    bf16_t* GB = (bf16_t*)(a.ws() + WS_GB); bf16_t* GBm = (bf16_t*)(a.ws() + WS_META + MT_GB);
    const float* cw = a.in(I_CONVW) + l * 3 * 512; const float* cb = a.in(I_CONVB) + l * 512;
    for (int i = gt; i < (MROWS + NMETA) * 64; i += NGT) { const int r = i >> 6, c = (i & 63) * 8;
        const bf16_t *cur, *p1, *p2; bf16_t* dst;
        if (r < MROWS) { const int t = r & 2047; cur = PA + (size_t)r * PA_N; p1 = (t >= 1) ? cur - PA_N : PM + 15 * PA_N; p2 = (t >= 2) ? cur - 2 * PA_N : (t == 1 ? PM + 15 * PA_N : PM + 14 * PA_N); dst = GB + (size_t)r * 512 + c; }
        else { const int t = r - MROWS; cur = PM + (size_t)t * PA_N; p1 = (t >= 1) ? cur - PA_N : nullptr; p2 = (t >= 2) ? cur - 2 * PA_N : nullptr; dst = GBm + (size_t)t * 512 + c; }
        const u32x4 xb0 = *(const u32x4*)(cur + OFF_XBAR + c), cg0 = *(const u32x4*)(cur + OFF_CG + c), bg = *(const u32x4*)(cur + OFF_BG + c);
        u32x4 xb1 = (u32x4){0u, 0u, 0u, 0u}, cg1 = xb1, xb2 = xb1, cg2 = xb1;
        if (p1) { xb1 = *(const u32x4*)(p1 + OFF_XBAR + c); cg1 = *(const u32x4*)(p1 + OFF_CG + c); }
        if (p2) { xb2 = *(const u32x4*)(p2 + OFF_XBAR + c); cg2 = *(const u32x4*)(p2 + OFF_CG + c); }
        u32x4 o;
#pragma unroll
        for (int q = 0; q < 4; ++q) {
            const int ce = c + 2 * q;
            const float u0l = bflo(cg0[q]) * bflo(xb0[q]), u0h = bfhi(cg0[q]) * bfhi(xb0[q]);
            const float u1l = bflo(cg1[q]) * bflo(xb1[q]), u1h = bfhi(cg1[q]) * bfhi(xb1[q]);
            const float u2l = bflo(cg2[q]) * bflo(xb2[q]), u2h = bfhi(cg2[q]) * bfhi(xb2[q]);
            const float yl = cb[ce] + cw[ce] * u2l + cw[512 + ce] * u1l + cw[1024 + ce] * u0l;
            const float yh = cb[ce + 1] + cw[ce + 1] * u2h + cw[512 + ce + 1] * u1h + cw[1024 + ce + 1] * u0h;
            o[q] = pk2(bflo(bg[q]) * yl, bfhi(bg[q]) * yh); }
        *(u32x4*)dst = o; }
}
__device__ __forceinline__ void stage_s5(const Args& a, int l, unsigned char* lds) {
    float* E = (float*)lds; float* Cp = (float*)(lds + 4096); float* Xs = (float*)(lds + 12288);
    const int tid = threadIdx.x, lane = tid & 63, wid = tid >> 6;
    const bf16_t* PA = (const bf16_t*)(a.ws() + WS_R1); const bf16_t* PM = (const bf16_t*)(a.ws() + WS_META + MT_PROJ);
    bf16_t* YC = (bf16_t*)(a.ws() + WS_YC); bf16_t* YCm = (bf16_t*)(a.ws() + WS_META + MT_YC);
    const float* AB = (const float*)(a.ws() + WS_TAB + TAB_AB); const float* BBR = (const float*)(a.ws() + WS_TAB + TAB_BBR); const float* BBI = (const float*)(a.ws() + WS_TAB + TAB_BBI);
    float* xs = Xs + wid * (16 * 129);
    for (int it = (int)blockIdx.x; it < NB * 32; it += (int)gridDim.x) {
        const int b = it >> 5, g = it & 31, pi_ = (l * 32 + g) * 64 + lane;
        const float abr = AB[2 * pi_], abi = AB[2 * pi_ + 1];
        float br[16], bi[16];
#pragma unroll
        for (int h = 0; h < 16; ++h) { br[h] = BBR[(size_t)pi_ * 16 + h]; bi[h] = BBI[(size_t)pi_ * 16 + h]; }
        __syncthreads();
        for (int idx = tid; idx < 2048; idx += 512) { const int k = idx >> 4, h = idx & 15;
            Cp[idx] = (k < 64) ? a.in(I_SCRE)[((size_t)(l * 32 + g) * 16 + h) * 64 + k] : -a.in(I_SCIM)[((size_t)(l * 32 + g) * 16 + h) * 64 + (k - 64)]; }
        const int uoff = OFF_U + 16 * g;
        const bf16_t* ubase = PA + ((size_t)b * SEQ + 256 * wid) * PA_N + uoff;
        float xr = 0.f, xi = 0.f;
#define S5_STEP(UP) do { const u32x4 w0_ = *(const u32x4*)(UP), w1_ = *(const u32x4*)((UP) + 8); float bur = 0.f, bui = 0.f; \
            _Pragma("unroll") for (int q = 0; q < 4; ++q) { const float ul = bflo(w0_[q]), uh = bfhi(w0_[q]), vl = bflo(w1_[q]), vh = bfhi(w1_[q]); \
                bur += br[2 * q] * ul + br[2 * q + 1] * uh + br[8 + 2 * q] * vl + br[8 + 2 * q + 1] * vh; bui += bi[2 * q] * ul + bi[2 * q + 1] * uh + bi[8 + 2 * q] * vl + bi[8 + 2 * q + 1] * vh; } \
            const float nxr = abr * xr - abi * xi + bur, nxi = abr * xi + abi * xr + bui; xr = nxr; xi = nxi; } while (0)
        if (wid == 0) for (int r = 0; r < NMETA; ++r) S5_STEP(PM + (size_t)r * PA_N + uoff);
        for (int t = 0; t < 256; ++t) S5_STEP(ubase + (size_t)t * PA_N);
        E[(wid * 64 + lane) * 2] = xr; E[(wid * 64 + lane) * 2 + 1] = xi;
        __syncthreads();
        float pr = abr, pim = abi;
#pragma unroll
        for (int s = 0; s < 8; ++s) { const float nr = pr * pr - pim * pim, ni = 2.f * pr * pim; pr = nr; pim = ni; }
        xr = 0.f; xi = 0.f;
        for (int v = 0; v < wid; ++v) { const float er = E[(v * 64 + lane) * 2], ei = E[(v * 64 + lane) * 2 + 1]; const float nr = pr * xr - pim * xi + er, ni = pr * xi + pim * xr + ei; xr = nr; xi = ni; }
        const int tl = lane >> 2, hq = lane & 3;
        const f32x4 dv = *(const f32x4*)(a.in(I_SD) + (size_t)(l * 32 + g) * 16 + 4 * hq);
        for (int sc = (wid == 0 ? -1 : 0); sc < 16; ++sc) {
            const bf16_t* ub = (sc < 0) ? PM + uoff : ubase + (size_t)(16 * sc) * PA_N;
            for (int t = 0; t < 16; ++t) { S5_STEP(ub + (size_t)t * PA_N); xs[t * 129 + lane] = xr; xs[t * 129 + 64 + lane] = xi; }
            f32x4 acc = (f32x4){0.f, 0.f, 0.f, 0.f};
#pragma unroll 8
            for (int k = 0; k < 128; ++k) { const float xv = xs[tl * 129 + k]; const f32x4 cv = *(const f32x4*)(Cp + k * 16 + 4 * hq); acc = acc + cv * xv; }
            const f32x4 uv = unpack4(*(const u32x2*)(ub + (size_t)tl * PA_N + 4 * hq));
            f32x4 y = acc + dv * uv;
#pragma unroll
            for (int i = 0; i < 4; ++i) y[i] = gelu_tanh(y[i]);
            if (sc >= 0) *(u32x2*)(YC + ((size_t)b * SEQ + 256 * wid + 16 * sc + tl) * 512 + 16 * g + 4 * hq) = pack4(y);
            else if (b == 0) *(u32x2*)(YCm + (size_t)tl * 512 + 16 * g + 4 * hq) = pack4(y);
        }
#undef S5_STEP
    }
}
__device__ __forceinline__ void stage_attn_simple(const Args& a) {
    const int lane = threadIdx.x & 63, gw = blockIdx.x * 8 + (threadIdx.x >> 6), NGW = gridDim.x * 8;
    const bf16_t* KV = (const bf16_t*)(a.ws() + WS_KV); const bf16_t* KR = (const bf16_t*)(a.ws() + WS_KR);
    bf16_t* Q = (bf16_t*)(a.ws() + WS_Q); bf16_t* Qm = (bf16_t*)(a.ws() + WS_META + MT_Q);
    constexpr int NMAIN = MROWS * 8;
    for (int it = NMAIN + gw; it < NMAIN + NMETA * 8; it += NGW) {
        int h, pos; bf16_t* qp; size_t kvb;
        if (it < NMAIN) { h = it & 7; const int r = it >> 3; pos = 16 + (r & 2047); qp = Q + (size_t)r * 768; kvb = (size_t)(r >> 11) * LPAD; }
        else { const int j = it - NMAIN; h = j & 7; const int r = j >> 3; pos = r; qp = Qm + (size_t)r * 768; kvb = 0; }
        const float qa = bf2f(qp[h * 64 + lane]); const float qb = bf2f(qp[512 + h * 32 + (lane & 31)]);
        float m = -INFINITY, lsum = 0.f, o = 0.f;
        for (int kc = 0; kc * 64 <= pos; ++kc) {
            const int p = kc * 64 + lane; const bool valid = p <= pos;
            const bf16_t* kp = KV + (kvb + p) * 1024 + h * 128; const bf16_t* rp = KR + (kvb + p) * 32;
            float s = 0.f;
#pragma unroll
            for (int c = 0; c < 8; ++c) { const u32x4 w = *(const u32x4*)(kp + c * 8);
#pragma unroll
                for (int q = 0; q < 4; ++q) { s += __shfl(qa, c * 8 + 2 * q) * bflo(w[q]); s += __shfl(qa, c * 8 + 2 * q + 1) * bfhi(w[q]); } }
#pragma unroll
            for (int c = 0; c < 4; ++c) { const u32x4 w = *(const u32x4*)(rp + c * 8);
#pragma unroll
                for (int q = 0; q < 4; ++q) { s += __shfl(qb, c * 8 + 2 * q) * bflo(w[q]); s += __shfl(qb, c * 8 + 2 * q + 1) * bfhi(w[q]); } }
            s = valid ? s : -INFINITY;
            const float mn = fmaxf(m, wave_max(s)); const float alpha = exp2f(m - mn); const float pj = valid ? exp2f(s - mn) : 0.f;
            lsum = lsum * alpha + wave_sum(pj); o *= alpha; m = mn;
            const int nj = min(64, pos + 1 - kc * 64);
            const bf16_t* vp = KV + (kvb + kc * 64) * 1024 + h * 128 + 64 + lane;
            for (int j = 0; j < nj; ++j) o += __shfl(pj, j) * bf2f(vp[(size_t)j * 1024]);
        }
        qp[h * 64 + lane] = (bf16_t)f2bf(o / lsum);
    }
}


typedef float f32x16 __attribute__((ext_vector_type(16)));
typedef short v4i16_t __attribute__((ext_vector_type(4)));
constexpr int AT_KB = 12288, AT_VB = 8192, AT_BUF = AT_KB + AT_VB, AT_WSF = 2 * AT_BUF;
__device__ __forceinline__ unsigned cvtpk(float lo, float hi) { typedef float f2 __attribute__((ext_vector_type(2))); typedef __bf16 b2 __attribute__((ext_vector_type(2))); f2 v = {lo, hi}; b2 b = __builtin_convertvector(v, b2); return __builtin_bit_cast(unsigned, b); }
__device__ __forceinline__ void attn_unit(const bf16_t* KV, const bf16_t* KR, bf16_t* Q, int b, int h, int qb, LAS unsigned char* lds) {
    const int tid = threadIdx.x, lane = tid & 63, wid = __builtin_amdgcn_readfirstlane(tid >> 6), r32 = lane & 31, hi = lane >> 5;
    const size_t kvb = (size_t)b * LPAD;
    const int NT = 4 * qb + 5;
    const int qrow0 = b * SEQ + 256 * qb + 32 * wid;
    const int qpos = 16 + 256 * qb + 32 * wid + r32;
    const int qpos_lo = 16 + 256 * qb + 32 * wid, qpos_hi = qpos_lo + 31;
    bf16x8 qf[6];
    { const bf16_t* qp = Q + (size_t)(qrow0 + r32) * 768;
#pragma unroll
      for (int s = 0; s < 4; ++s) qf[s] = *(const bf16x8*)(qp + h * 64 + 16 * s + 8 * hi);
#pragma unroll
      for (int s = 0; s < 2; ++s) qf[4 + s] = *(const bf16x8*)(qp + 512 + h * 32 + 16 * s + 8 * hi); }
    const bf16_t* gk = KV + (kvb + lane) * 1024 + h * 128 + 8 * wid;
    const bf16_t* gr = KR + (kvb + lane) * 32 + 8 * (wid & 3);
    const bf16_t* gv = KV + (kvb + 16 * (wid & 3) + (lane >> 2)) * 1024 + h * 128 + 64 + (wid >> 2) * 32 + (lane & 3) * 8;
    const int sk = wid * 1024 + lane * 16, sr = (8 + (wid & 3)) * 1024 + lane * 16, sv = AT_KB + wid * 1024 + lane * 16;
    const int kread = hi * 1024 + r32 * 16;
    const int vread = AT_KB + ((lane >> 4) & 1) * 32 + (lane & 3) * 8 + (4 * hi + ((lane & 15) >> 2)) * 64;
    LAS float* wsf = (LAS float*)(lds + AT_WSF) + wid * 32;
    u32x4 stk, str_ = (u32x4){0u, 0u, 0u, 0u}, stv;
    stk = *(const u32x4*)gk; if (wid < 4) str_ = *(const u32x4*)gr; stv = *(const u32x4*)gv;
    *(LAS u32x4*)(lds + sk) = stk; if (wid < 4) *(LAS u32x4*)(lds + sr) = str_; *(LAS u32x4*)(lds + sv) = stv;
    __syncthreads();
    f32x16 o0 = {}, o1 = {};
    float m = -INFINITY, lsum = 0.f;
    for (int j = 0; j < NT; ++j) {
        LAS unsigned char* buf = lds + (j & 1) * AT_BUF;
        LAS unsigned char* nbuf = lds + ((j + 1) & 1) * AT_BUF;
        const bool more = (j + 1 < NT);
        if (more) { const size_t go = (size_t)(j + 1) * 64; stk = *(const u32x4*)(gk + go * 1024); if (wid < 4) str_ = *(const u32x4*)(gr + go * 32); stv = *(const u32x4*)(gv + go * 1024); }
        if (64 * j <= qpos_hi) {
            f32x16 p0 = {}, p1 = {};
#pragma unroll
            for (int s = 0; s < 6; ++s) {
                const bf16x8 k0 = *(const LAS bf16x8*)(buf + kread + s * 2048), k1 = *(const LAS bf16x8*)(buf + kread + s * 2048 + 512);
                p0 = __builtin_amdgcn_mfma_f32_32x32x16_bf16(k0, qf[s], p0, 0, 0, 0);
                p1 = __builtin_amdgcn_mfma_f32_32x32x16_bf16(k1, qf[s], p1, 0, 0, 0);
            }
            if (64 * j + 63 > qpos_lo) {
#pragma unroll
                for (int r = 0; r < 16; ++r) { const int kp = 64 * j + (r & 3) + 8 * (r >> 2) + 4 * hi; if (kp > qpos) p0[r] = -INFINITY; if (kp + 32 > qpos) p1[r] = -INFINITY; }
            }
            float mx = fmaxf(p0[0], p1[0]);
#pragma unroll
            for (int r = 1; r < 16; ++r) mx = fmaxf(mx, fmaxf(p0[r], p1[r]));
            mx = fmaxf(mx, __shfl_xor(mx, 32));
            const float mn = fmaxf(m, mx);
            const bool grow = mn > m;
            const float alpha = exp2f(m - mn);
            m = mn;
            float ps = 0.f;
#pragma unroll
            for (int r = 0; r < 16; ++r) { p0[r] = exp2f(p0[r] - mn); p1[r] = exp2f(p1[r] - mn); ps += p0[r] + p1[r]; }
            lsum = lsum * alpha + ps;
            if (__any(grow)) {
                if (hi == 0) wsf[r32] = alpha;
#pragma unroll
                for (int g = 0; g < 4; ++g) { const f32x4 av = *(const LAS f32x4*)(wsf + 8 * g + 4 * hi);
#pragma unroll
                    for (int i = 0; i < 4; ++i) { o0[4 * g + i] *= av[i]; o1[4 * g + i] *= av[i]; } }
            }
            u32x4 pw[4];
#pragma unroll
            for (int q = 0; q < 4; ++q) { pw[0][q] = cvtpk(p0[2 * q], p0[2 * q + 1]); pw[1][q] = cvtpk(p0[8 + 2 * q], p0[8 + 2 * q + 1]); pw[2][q] = cvtpk(p1[2 * q], p1[2 * q + 1]); pw[3][q] = cvtpk(p1[8 + 2 * q], p1[8 + 2 * q + 1]); }
#pragma unroll
            for (int ks = 0; ks < 4; ++ks) {
                const bf16x8 pa = __builtin_bit_cast(bf16x8, pw[ks]);
#pragma unroll
                for (int d0 = 0; d0 < 2; ++d0) {
                    const v4i16_t lo = __builtin_amdgcn_ds_read_tr16_b64_v4i16((LAS v4i16_t*)(buf + vread + d0 * 4096 + ks * 1024));
                    const v4i16_t hh = __builtin_amdgcn_ds_read_tr16_b64_v4i16((LAS v4i16_t*)(buf + vread + d0 * 4096 + ks * 1024 + 512));
                    const bf16x8 vf = (bf16x8){lo[0], lo[1], lo[2], lo[3], hh[0], hh[1], hh[2], hh[3]};
                    if (d0 == 0) o0 = __builtin_amdgcn_mfma_f32_32x32x16_bf16(pa, vf, o0, 0, 0, 0); else o1 = __builtin_amdgcn_mfma_f32_32x32x16_bf16(pa, vf, o1, 0, 0, 0);
                }
            }
        }
        if (more) { *(LAS u32x4*)(nbuf + sk) = stk; if (wid < 4) *(LAS u32x4*)(nbuf + sr) = str_; *(LAS u32x4*)(nbuf + sv) = stv; }
        __syncthreads();
    }
    lsum += __shfl_xor(lsum, 32);
    if (hi == 0) wsf[r32] = 1.0f / lsum;
    bf16_t* op = Q + (size_t)qrow0 * 768 + h * 64 + r32;
#pragma unroll
    for (int g = 0; g < 4; ++g) { const f32x4 av = *(const LAS f32x4*)(wsf + 8 * g + 4 * hi);
#pragma unroll
        for (int i = 0; i < 4; ++i) { const int row = 8 * g + 4 * hi + i; op[(size_t)row * 768] = (bf16_t)f2bf(o0[4 * g + i] * av[i]); op[(size_t)row * 768 + 32] = (bf16_t)f2bf(o1[4 * g + i] * av[i]); } }
    __syncthreads();
}
__device__ __forceinline__ void stage_attn_mfma(const Args& a, unsigned char* lds) {
    const bf16_t* KV = (const bf16_t*)(a.ws() + WS_KV); const bf16_t* KR = (const bf16_t*)(a.ws() + WS_KR); bf16_t* Q = (bf16_t*)(a.ws() + WS_Q);
    const int G = (int)gridDim.x, bx = (int)blockIdx.x, vcu = (G % 8 == 0) ? (bx % 8) * (G / 8) + bx / 8 : bx;
    __syncthreads();
    for (int pr = vcu; pr < 256; pr += G) {
        const int bh = pr >> 2, s = pr & 3;
        attn_unit(KV, KR, Q, bh >> 3, bh & 7, 7 - s, (LAS unsigned char*)lds);
        attn_unit(KV, KR, Q, bh >> 3, bh & 7, s, (LAS unsigned char*)lds);
    }
}

constexpr int N_STAGES = 25;
template <int st> __device__ __forceinline__ void run_stage(unsigned char* lds) {
    int opq; asm volatile("s_mov_b32 %0, 0" : "=s"(opq));
    Args a; a.kp = (const void* CAS const*)__builtin_amdgcn_kernarg_segment_ptr(); a.opq = opq;
    float* scr = (float*)lds;
    unsigned char* ws = a.ws();
    bf16_t* XN = (bf16_t*)(ws + WS_XN); bf16_t* R1 = (bf16_t*)(ws + WS_R1); bf16_t* Q = (bf16_t*)(ws + WS_Q); bf16_t* KV = (bf16_t*)(ws + WS_KV);
    bf16_t* GB = (bf16_t*)(ws + WS_GB); bf16_t* YC = (bf16_t*)(ws + WS_YC); bf16_t* YG = (bf16_t*)(ws + WS_YG); float* SS = (float*)(ws + WS_SS);
    unsigned char* mt = ws + WS_META;
    float* Xm = (float*)(mt + MT_X); bf16_t* XNm = (bf16_t*)(mt + MT_XN); bf16_t* Hm = (bf16_t*)(mt + MT_H); bf16_t* PM = (bf16_t*)(mt + MT_PROJ); bf16_t* Qm = (bf16_t*)(mt + MT_Q);
    bf16_t* GBm = (bf16_t*)(mt + MT_GB); bf16_t* YCm = (bf16_t*)(mt + MT_YC); bf16_t* YGm = (bf16_t*)(mt + MT_YG); bf16_t* SGm = (bf16_t*)(mt + MT_SG); bf16_t* MXm = (bf16_t*)(mt + MT_MIX); float* SSm = (float*)(mt + MT_SS);
    const float* rc = (const float*)(ws + WS_TAB + TAB_COS); const float* rs = (const float*)(ws + WS_TAB + TAB_SIN);
    if (st == 0) { stage_prologue(a, scr); return; }
    constexpr int l = (st - 1) / 12, s = (st - 1) % 12;
    const float* xin = (l == 0) ? a.in(I_X) : a.out();
    if (s == 0 || s == 9) {
        const int p = (s == 0) ? 1 : 8; const bf16_t* W = slot_ptr(a, 9 * l + p);
        gemm_eng(lds, XN, DM, W, DM, NGU, EpiSwiglu{R1, DFF});
        gemm_meta(XNm, DM, W, DM, NGU, EpiSwiglu{Hm, DFF}, scr);
        convert_next(a, l, p, scr);
    } else if (s == 1 || s == 10) {
        const int p = (s == 1) ? 2 : 9; const bf16_t* W = slot_ptr(a, 9 * l + p);
        const float* xi_ = (s == 1) ? xin : a.out();
        gemm_eng(lds, R1, DFF, W, DFF, DM, EpiResid{xi_, a.out(), ALPHA, 0.5f});
        gemm_meta(Hm, DFF, W, DFF, DM, EpiResid{Xm, Xm, ALPHA, 0.5f}, scr);
        convert_next(a, l, p, scr);
    } else if (s == 2) { stage_ln(a, a.in(I_LN1G) + l * DM, a.in(I_LN1B) + l * DM);
    } else if (s == 8) { stage_ln(a, a.in(I_LN2G) + l * DM, a.in(I_LN2B) + l * DM);
    } else if (s == 11) { stage_ln(a, a.in(I_LN3G) + l * DM, a.in(I_LN3B) + l * DM);
    } else if (s == 3) {
        const bf16_t* W = slot_ptr(a, 9 * l + 3);
        gemm_eng(lds, XN, DM, W, DM, PA_N, EpiProjA{R1, SS});
        gemm_meta(XNm, DM, W, DM, PA_N, EpiProjA{PM, SSm}, scr);
        convert_next(a, l, 3, scr);
    } else if (s == 4) {
        const bf16_t* W = slot_ptr(a, 9 * l + 4);
        gemm_eng(lds, R1, PA_N, W, 384, 768, EpiUq{Q, SS, rc, rs, 16, 2047});
        gemm_meta(PM, PA_N, W, 384, 768, EpiUq{Qm, SSm, rc, rs, 0, 15}, scr);
        gemm_eng(lds, R1 + OFF_CKV, PA_N, W + (1 * MiB) / 2, 256, 1024, EpiUkv{KV, SS, 0});
        gemm_meta(PM + OFF_CKV, PA_N, W + (1 * MiB) / 2, 256, 1024, EpiUkv{KV, SSm, 1}, scr);
        stage_krope_pad(a);
        stage_conv(a, l);
        __syncthreads();
        stage_s5(a, l, lds);
        __syncthreads();
        convert_next(a, l, 4, scr);
    } else if (s == 5) {
        const bf16_t* W = slot_ptr(a, 9 * l + 5);
        stage_attn_mfma(a, lds);
        stage_attn_simple(a);
        gemm_eng(lds, YC, 512, W + (8 * MiB) / 2, 512, 512, EpiGlu{YG, YC, a.in(I_BGLU) + l * 512});
        gemm_meta(YCm, 512, W + (8 * MiB) / 2, 512, 512, EpiGlu{YGm, YCm, a.in(I_BGLU) + l * 512}, scr);
        gemm_eng(lds, XN, DM, W, DM, 3072, EpiSig{R1});
        gemm_meta(XNm, DM, W, DM, 3072, EpiSig{SGm}, scr);
        convert_next(a, l, 5, scr);
    } else if (s == 6) {
        const bf16_t* W = slot_ptr(a, 9 * l + 6);
        gemm_eng(lds, Q, 768, W, 512, DM, EpiMerge{KV, R1, 0, 1});
        gemm_eng(lds, GB, 512, W + (1 * MiB) / 2, 512, DM, EpiMerge{KV, R1, 1, 0});
        gemm_eng(lds, YG, 512, W + (2 * MiB) / 2, 512, DM, EpiMerge{KV, R1, 2, 0});
        gemm_meta(Qm, 768, W, 512, DM, EpiMerge{MXm, SGm, 0, 1}, scr);
        gemm_meta(GBm, 512, W + (1 * MiB) / 2, 512, DM, EpiMerge{MXm, SGm, 1, 0}, scr);
        gemm_meta(YGm, 512, W + (2 * MiB) / 2, 512, DM, EpiMerge{MXm, SGm, 2, 0}, scr);
        convert_next(a, l, 6, scr);
    } else if (s == 7) {
        const bf16_t* W = slot_ptr(a, 9 * l + 7);
        gemm_eng(lds, KV, DM, W, DM, DM, EpiResid{a.out(), a.out(), ALPHA, 1.0f});
        gemm_meta(MXm, DM, W, DM, DM, EpiResid{Xm, Xm, ALPHA, 1.0f}, scr);
        convert_next(a, l, 7, scr);
    }
}

#define XB_TMO      128
#define XB_XCNT(j)  (256  + 64 * (j))
#define XB_XSUB(j)  (1280 + 64 * (j))
#define XB_XGEN(j)  (2304 + 64 * (j))
#define XB_TOP      3328
#define XB_TOPGEN   3392
#define XCD_BAR_WORDS 3456
#define XB_SPIN_CAP (1u << 18)
__device__ __forceinline__ unsigned xb_ld(unsigned* p)              { return __hip_atomic_load(p, __ATOMIC_RELAXED, __HIP_MEMORY_SCOPE_AGENT); }
__device__ __forceinline__ unsigned xb_add(unsigned* p, unsigned v) { return __hip_atomic_fetch_add(p, v, __ATOMIC_RELAXED, __HIP_MEMORY_SCOPE_AGENT); }
__device__ __forceinline__ unsigned xb_xcc_id() { return (unsigned)__builtin_amdgcn_s_getreg((3 << 11) | 20) & 0xFu; }
#define XB_SPIN(cond, bar) do { unsigned _sp = 0; while (cond) { __builtin_amdgcn_s_sleep(1); \
    if ((++_sp & 255u) == 0u) { if (xb_ld(&(bar)[XB_TMO])) break; if (_sp > XB_SPIN_CAP) { atomicAdd(&(bar)[XB_TMO], 1u); break; } } } } while (0)
struct XcdBarrier { unsigned* bar; unsigned x; volatile LAS unsigned* st; };
__device__ __forceinline__ XcdBarrier xcd_barrier_post(unsigned* bar, volatile LAS unsigned* st) {
    XcdBarrier b; b.bar = bar; b.x = xb_xcc_id(); b.st = st;
    if (threadIdx.x == 0) (void)xb_add(&bar[XB_XCNT(b.x)], 1u);
    return b;
}
__device__ __forceinline__ void xcd_barrier_complete(unsigned* bar, unsigned x, unsigned& nloc, unsigned& nx) {
    const unsigned G = gridDim.x * gridDim.y * gridDim.z;
    unsigned sum, cnt, mine, sp = 0u;
    for (;;) {
        sum = 0u; cnt = 0u; mine = 0u;
#pragma unroll
        for (unsigned j = 0; j < 16; ++j) { const unsigned c = xb_ld(&bar[XB_XCNT(j)]); sum += c; cnt += (c > 0u) ? 1u : 0u; mine = (j == x) ? c : mine; }
        if (sum == G) break;
        __builtin_amdgcn_s_sleep(1);
        if ((++sp & 255u) == 0u) { if (xb_ld(&bar[XB_TMO])) break; if (sp > XB_SPIN_CAP) { atomicAdd(&bar[XB_TMO], 1u); break; } }
    }
    nloc = mine > 0u ? mine : 1u; nx = cnt > 0u ? cnt : 1u;
}
__device__ __forceinline__ void xcd_barrier(const XcdBarrier& b) {
    asm volatile("s_waitcnt vmcnt(0)" ::: "memory");
    __syncthreads();
    if (threadIdx.x == 0) {
        unsigned* bar = b.bar;
        __builtin_amdgcn_s_waitcnt(0);
        unsigned nloc = b.st[0], nx = b.st[1];
        if (nloc == 0u) { xcd_barrier_complete(bar, b.x, nloc, nx); b.st[0] = nloc; b.st[1] = nx; }
        const unsigned old = xb_add(&bar[XB_XSUB(b.x)], 1u);
        const unsigned gen = old / nloc;
        if (old + 1u == (gen + 1u) * nloc) {
            __builtin_amdgcn_fence(__ATOMIC_RELEASE, "agent");
            asm volatile("s_waitcnt vmcnt(0)" ::: "memory");
            const unsigned og = xb_add(&bar[XB_TOP], 1u);
            const unsigned tg = og / nx;
            if (og + 1u == (tg + 1u) * nx) xb_add(&bar[XB_TOPGEN], 1u);
            else XB_SPIN(xb_ld(&bar[XB_TOPGEN]) == tg, bar);
            __builtin_amdgcn_fence(__ATOMIC_ACQUIRE, "agent");
            xb_add(&bar[XB_XGEN(b.x)], 1u);
            asm volatile("s_waitcnt vmcnt(0)" ::: "memory");
        } else {
            XB_SPIN(xb_ld(&bar[XB_XGEN(b.x)]) == gen, bar);
            __builtin_amdgcn_fence(__ATOMIC_ACQUIRE, "agent");
            asm volatile("s_waitcnt vmcnt(0)" ::: "memory");
        }
    }
    __syncthreads();
}

template <int ST> __device__ __forceinline__ void run_from(unsigned char* lds, const XcdBarrier& bar, int lo, int hi) {
    if constexpr (ST < N_STAGES) {
        if (lo <= ST && ST < hi) {
            run_stage<ST>(lds);
            if (ST + 1 < hi) { if (ST == 0) cooperative_groups::this_grid().sync(); else xcd_barrier(bar); }
        }
        run_from<ST + 1>(lds, bar, lo, hi);
    }
}
constexpr int LDSCTL_OFF = 131072, MISC_OFF = LDSCTL_OFF + 320;
constexpr int CW_BAR = 4096;
struct KArgs { const void* p[N_IN + 2]; int st_lo, st_hi; };

__global__ void __launch_bounds__(512, 2) mk_fwd(KArgs ka) {
    extern __shared__ __attribute__((aligned(16))) unsigned char lds[];
    namespace cg = cooperative_groups;
    const bool multi = (ka.st_hi - ka.st_lo) > 1;
    XcdBarrier bar; bar.bar = nullptr; bar.x = 0; bar.st = nullptr;
    if (multi) {
        for (int u = threadIdx.x; u < (LDS_BYTES - LDSCTL_OFF) / 4; u += 512) ((LAS unsigned*)((LAS unsigned char*)lds + LDSCTL_OFF))[u] = 0u;
        __syncthreads();
        unsigned* ctl = (unsigned*)((unsigned char*)ka.p[N_IN + 1] + WS_CTL);
        bar = xcd_barrier_post(ctl + CW_BAR, (volatile LAS unsigned*)((LAS unsigned char*)lds + MISC_OFF) + 8);
    }
    run_from<0>(lds, bar, ka.st_lo, ka.st_hi);
}

extern "C" void kernel_launch(void* const* d_in, const int* in_sizes, int n_in, void* d_out, int out_size, void* d_ws, size_t ws_size, hipStream_t stream) {
    static int grid = 0;
    if (grid == 0) {
        if (n_in != N_IN || out_size != MROWS * DM || ws_size < WS_END) { fprintf(stderr, "kernel_launch: unexpected shapes (n_in %d, out %d, ws %zu)\n", n_in, out_size, ws_size); grid = -1; return; }
        int dev = 0, cus = 0, per_cu = 0;
        if (hipGetDevice(&dev) != hipSuccess || hipDeviceGetAttribute(&cus, hipDeviceAttributeMultiprocessorCount, dev) != hipSuccess) { grid = -1; return; }
        if (hipFuncSetAttribute((const void*)mk_fwd, hipFuncAttributeMaxDynamicSharedMemorySize, LDS_BYTES) != hipSuccess) { fprintf(stderr, "kernel_launch: hipFuncSetAttribute failed\n"); grid = -1; return; }
        if (hipOccupancyMaxActiveBlocksPerMultiprocessor(&per_cu, (const void*)mk_fwd, 512, LDS_BYTES) != hipSuccess || per_cu < 1) { fprintf(stderr, "kernel_launch: occupancy query says %d blocks per CU\n", per_cu); (void)hipGetLastError(); grid = -1; return; }
        grid = cus;
    }
    if (grid < 0) return;
    (void)hipMemsetAsync((char*)d_ws + WS_CTL, 0, CTL_BYTES, stream);
    KArgs a{};
    for (int i = 0; i < N_IN; ++i) a.p[i] = d_in[i];
    a.p[N_IN] = d_out; a.p[N_IN + 1] = d_ws; a.st_lo = 0; a.st_hi = N_STAGES;
    void* args[] = {&a};
    hipError_t e = hipLaunchCooperativeKernel((const void*)mk_fwd, dim3(grid), dim3(512), args, LDS_BYTES, stream);
    if (e != hipSuccess) fprintf(stderr, "kernel_launch: cooperative launch failed: %s (grid %d)\n", hipGetErrorString(e), grid);
}
```
